# Optimizing an MI355X kernel written in HIP

```python
import math
import jax, jax.numpy as jnp
from jax import lax
import numpy as np

D_MODEL = 1024
BATCH = 8
SEQ = 2048
DEPTH = 1

CHUNK = 64

MIX_WIDTH = D_MODEL
POOL_WIDTH = MIX_WIDTH // 2
POOL_WINDOWS = (2, 4, 8, 16)
POOL_GROUPS = len(POOL_WINDOWS)
POOL_GROUP_DIM = POOL_WIDTH // POOL_GROUPS
SB_WIDTH = MIX_WIDTH - POOL_WIDTH
SB_HEADS = 8
SB_HEAD_DIM = SB_WIDTH // SB_HEADS
Q_BLOCK = 128
IN_PROJ_WIDTH = POOL_WIDTH + 3 * SB_WIDTH

PEER_HEADS = 8
PEER_N_KEYS = 128
PEER_N_EXPERTS = PEER_N_KEYS * PEER_N_KEYS
PEER_TOPK = 16
PEER_KEY_DIM = 256
PEER_HALF_DIM = PEER_KEY_DIM // 2
PEER_TOKEN_BLOCK = 128

LN_EPS = 1e-5
DN_ALPHA = (2.0 * DEPTH) ** 0.25
DN_BETA = (8.0 * DEPTH) ** -0.25

kernel_name = "hybrid_pool_stickbreak_peer_deepnorm"


def layer_norm(x, g, b):
    xf = x.astype(jnp.float32)
    mu = jnp.mean(xf, axis=-1, keepdims=True)
    var = jnp.mean(jnp.square(xf - mu), axis=-1, keepdims=True)
    y = (xf - mu) * lax.rsqrt(var + LN_EPS) * g.astype(jnp.float32) + b.astype(jnp.float32)
    return y.astype(x.dtype)


def pool_mixer(u, pool_w, pool_b, pool_scale):
    B, S, _ = u.shape
    ug = u.reshape(B, S, POOL_GROUPS, POOL_GROUP_DIM).astype(jnp.float32)
    cs = jnp.cumsum(ug, axis=1)
    pos = jnp.arange(S)
    outs = []
    for g, w in enumerate(POOL_WINDOWS):
        c = cs[:, :, g]
        shifted = jnp.pad(c, ((0, 0), (w, 0), (0, 0)))[:, :S]
        count = jnp.minimum(pos + 1, w).astype(jnp.float32)[None, :, None]
        outs.append((c - shifted) / count - ug[:, :, g])
    pooled = jnp.stack(outs, axis=2).astype(u.dtype)
    mixed = jnp.einsum('bsgc,gcd->bsgd', pooled, pool_w) + pool_b
    return mixed.reshape(B, S, POOL_WIDTH) * pool_scale


def stick_breaking_attention(q, k, v):
    S = q.shape[2]
    scale = 1.0 / math.sqrt(SB_HEAD_DIM)
    outs = []
    for i in range(S // Q_BLOCK):
        q0 = i * Q_BLOCK
        kend = q0 + Q_BLOCK
        z = jnp.einsum('bhqd,bhkd->bhqk', q[:, :, q0:kend], k[:, :, :kend]).astype(jnp.float32) * scale
        t_idx = q0 + jnp.arange(Q_BLOCK)[:, None]
        s_idx = jnp.arange(kend)[None, :]
        mask = s_idx < t_idx
        log_1m_beta = jnp.where(mask, jax.nn.log_sigmoid(-z), 0.0)
        after = lax.cumsum(log_1m_beta, axis=3, reverse=True) - log_1m_beta
        a = jnp.where(mask, jnp.exp(jax.nn.log_sigmoid(z) + after), 0.0)
        outs.append(jnp.einsum('bhqk,bhkd->bhqd', a.astype(v.dtype), v[:, :, :kend]))
    return jnp.concatenate(outs, axis=2)


def hybrid_mixer(x, w_in, pool_w, pool_b, pool_scale, w_out):
    B, S, _ = x.shape
    h = x @ w_in
    u = h[..., :POOL_WIDTH]
    qkv = h[..., POOL_WIDTH:].reshape(B, S, 3, SB_HEADS, SB_HEAD_DIM)
    q = jnp.transpose(qkv[:, :, 0], (0, 2, 1, 3))
    k = jnp.transpose(qkv[:, :, 1], (0, 2, 1, 3))
    v = jnp.transpose(qkv[:, :, 2], (0, 2, 1, 3))
    a_out = pool_mixer(u, pool_w, pool_b, pool_scale)
    b_out = jnp.transpose(stick_breaking_attention(q, k, v), (0, 2, 1, 3)).reshape(B, S, SB_WIDTH)
    return jnp.concatenate([a_out, b_out], axis=-1) @ w_out


def peer(x, w_query, sub_keys, u_table, v_table):
    B, S, D = x.shape
    T = B * S
    xt = x.reshape(T, D)
    q = (xt @ w_query).reshape(T, PEER_HEADS, 2, PEER_HALF_DIM)
    scores = jnp.einsum('thpc,pnc->thpn', q, sub_keys).astype(jnp.float32)
    top_s, top_i = lax.top_k(scores, PEER_TOPK)
    cand_s = (top_s[:, :, 0, :, None] + top_s[:, :, 1, None, :]).reshape(T, PEER_HEADS, PEER_TOPK * PEER_TOPK)
    cand_i = (top_i[:, :, 0, :, None] * PEER_N_KEYS + top_i[:, :, 1, None, :]).reshape(T, PEER_HEADS, PEER_TOPK * PEER_TOPK)
    best_s, best_pos = lax.top_k(cand_s, PEER_TOPK)
    expert_idx = jnp.take_along_axis(cand_i, best_pos, axis=-1)
    gate = jax.nn.softmax(best_s, axis=-1).astype(x.dtype)

    n_blocks = T // PEER_TOKEN_BLOCK

    def block_fn(args):
        xb, idx, g = args
        u_sel = u_table[idx]
        hid = jnp.einsum('td,thkd->thk', xb, u_sel)
        act = jax.nn.gelu(hid, approximate=False) * g
        v_sel = v_table[idx]
        return jnp.einsum('thk,thkd->td', act, v_sel)

    out = lax.map(block_fn, (xt.reshape(n_blocks, PEER_TOKEN_BLOCK, D),
                             expert_idx.reshape(n_blocks, PEER_TOKEN_BLOCK, PEER_HEADS, PEER_TOPK),
                             gate.reshape(n_blocks, PEER_TOKEN_BLOCK, PEER_HEADS, PEER_TOPK)))
    return out.reshape(B, S, D)


def setup_inputs(seed: int = 0) -> dict:
    key = jax.random.key(seed)
    ks = jax.random.split(key, 20)
    f32 = jnp.float32
    L = DEPTH
    D = D_MODEL

    def nrm(k, shape, scale):
        return jax.random.normal(k, shape, f32) * scale

    x = jax.random.normal(ks[0], (BATCH, SEQ, D), f32)
    ln0_g = 1.0 + nrm(ks[1], (D,), 0.02)
    ln0_b = nrm(ks[2], (D,), 0.02)
    w_in_pqk = nrm(ks[3], (L, D, POOL_WIDTH + 2 * SB_WIDTH), D ** -0.5)
    w_in_v = nrm(ks[4], (L, D, SB_WIDTH), D ** -0.5 * DN_BETA)
    w_in = jnp.concatenate([w_in_pqk, w_in_v], axis=-1)
    pool_w = nrm(ks[5], (L, POOL_GROUPS, POOL_GROUP_DIM, POOL_GROUP_DIM), POOL_GROUP_DIM ** -0.5)
    pool_b = nrm(ks[6], (L, POOL_GROUPS, POOL_GROUP_DIM), 0.02)
    pool_scale = 1.0 + nrm(ks[7], (L, POOL_WIDTH), 0.1)
    w_out = nrm(ks[8], (L, MIX_WIDTH, D), MIX_WIDTH ** -0.5 * DN_BETA)
    ln1_g = 1.0 + nrm(ks[9], (L, D), 0.02)
    ln1_b = nrm(ks[10], (L, D), 0.02)
    peer_wq = nrm(ks[11], (L, D, PEER_HEADS * PEER_KEY_DIM), D ** -0.5)
    peer_sub_keys = nrm(ks[12], (L, 2, PEER_N_KEYS, PEER_HALF_DIM), PEER_HALF_DIM ** -0.5)
    peer_u = nrm(ks[13], (L, PEER_N_EXPERTS, D), D ** -0.5)
    peer_v = nrm(ks[14], (L, PEER_N_EXPERTS, D), DN_BETA)
    ln2_g = 1.0 + nrm(ks[15], (L, D), 0.02)
    ln2_b = nrm(ks[16], (L, D), 0.02)
    return {"x": x, "ln0_g": ln0_g, "ln0_b": ln0_b, "w_in": w_in, "pool_w": pool_w,
            "pool_b": pool_b, "pool_scale": pool_scale, "w_out": w_out, "ln1_g": ln1_g,
            "ln1_b": ln1_b, "peer_wq": peer_wq, "peer_sub_keys": peer_sub_keys,
            "peer_u": peer_u, "peer_v": peer_v, "ln2_g": ln2_g, "ln2_b": ln2_b}


def reference(x, ln0_g, ln0_b, w_in, pool_w, pool_b, pool_scale, w_out, ln1_g, ln1_b,
              peer_wq, peer_sub_keys, peer_u, peer_v, ln2_g, ln2_b):
    h = layer_norm(x, ln0_g, ln0_b)
    for l in range(DEPTH):
        mix = hybrid_mixer(h, w_in[l], pool_w[l], pool_b[l], pool_scale[l], w_out[l])
        h = layer_norm(DN_ALPHA * h + mix, ln1_g[l], ln1_b[l])
        ffn = peer(h, peer_wq[l], peer_sub_keys[l], peer_u[l], peer_v[l])
        h = layer_norm(DN_ALPHA * h + ffn, ln2_g[l], ln2_b[l])
    return h
```

```cpp
#include <hip/hip_runtime.h>
#include <hip/hip_cooperative_groups.h>
#include <cstdio>
#include <cstdint>

namespace cg = cooperative_groups;

typedef unsigned short bf16_t;
typedef short bf16x8 __attribute__((ext_vector_type(8)));
typedef float f32x4 __attribute__((ext_vector_type(4)));
typedef float f32x16 __attribute__((ext_vector_type(16)));
typedef unsigned u32x4 __attribute__((ext_vector_type(4)));
typedef unsigned u32x2 __attribute__((ext_vector_type(2)));

constexpr int T_ = 16384, D_ = 1024, S_ = 2048;
constexpr int NTHREADS = 512, NWAVES = 8;
constexpr float LN_EPS = 1e-5f;
constexpr float DN_ALPHA = 1.189207115002721f;

constexpr size_t MB = 1024 * 1024;
constexpr size_t WS_CTL = 0;
constexpr size_t WS_H0B = 64 * 1024;
constexpr size_t WS_WIN = WS_H0B + 32 * MB;
constexpr size_t WS_WOUT = WS_WIN + 4 * MB;
constexpr size_t WS_WQ = WS_WOUT + 2 * MB;
constexpr size_t WS_POOLW = WS_WQ + 4 * MB;
constexpr size_t WS_SUBK = WS_POOLW + 256 * 1024;
constexpr size_t WS_UB = WS_SUBK + 64 * 1024;
constexpr size_t WS_VB = WS_UB + 32 * MB;
constexpr size_t WS_HCAT = WS_VB + 32 * MB;
constexpr size_t WS_VT = WS_HCAT + 48 * MB;
constexpr size_t WS_MIX = WS_VT + 16 * MB;
constexpr size_t WS_POOLED = WS_MIX + 32 * MB;
constexpr size_t WS_END = WS_POOLED + 16 * MB;

struct Params {
    const float *x, *ln0_g, *ln0_b, *w_in, *pool_w, *pool_b, *pool_scale, *w_out, *ln1_g, *ln1_b, *wq, *subk, *pu, *pv, *ln2_g, *ln2_b;
    float* out;
    unsigned char* ws;
};

typedef float f32x2 __attribute__((ext_vector_type(2)));
typedef __bf16 bf16x2n __attribute__((ext_vector_type(2)));
__device__ __forceinline__ unsigned pk_bf16(float lo, float hi) { const f32x2 v = {lo, hi}; return __builtin_bit_cast(unsigned, __builtin_convertvector(v, bf16x2n)); }
__device__ __forceinline__ bf16_t f2bf(float f) { return (bf16_t)(pk_bf16(f, 0.f) & 0xffffu); }
__device__ __forceinline__ float bf_lo(unsigned u) { return __uint_as_float(u << 16); }
__device__ __forceinline__ float bf_hi(unsigned u) { return __uint_as_float(u & 0xffff0000u); }
__device__ __forceinline__ float wave_sum(float v) {
#pragma unroll
    for (int o = 32; o > 0; o >>= 1) v += __shfl_xor(v, o);
    return v;
}

__device__ __forceinline__ void ln_row(const float* src, const float* g, const float* b, float* dst32, bf16_t* dst16, int lane) {
    f32x4 v[4];
    float s = 0.f;
#pragma unroll
    for (int i = 0; i < 4; ++i) { v[i] = *(const f32x4*)(src + lane * 4 + i * 256); s += (v[i][0] + v[i][1]) + (v[i][2] + v[i][3]); }
    const float mean = wave_sum(s) * (1.0f / 1024.0f);
    float q = 0.f;
#pragma unroll
    for (int i = 0; i < 4; ++i) { f32x4 d = v[i] - mean; q += (d[0] * d[0] + d[1] * d[1]) + (d[2] * d[2] + d[3] * d[3]); }
    const float rstd = rsqrtf(wave_sum(q) * (1.0f / 1024.0f) + LN_EPS);
#pragma unroll
    for (int i = 0; i < 4; ++i) {
        const f32x4 gg = *(const f32x4*)(g + lane * 4 + i * 256), bb = *(const f32x4*)(b + lane * 4 + i * 256);
        const f32x4 y = (v[i] - mean) * rstd * gg + bb;
        if (dst32) *(f32x4*)(dst32 + lane * 4 + i * 256) = y;
        if (dst16) { u32x2 o; o.x = pk_bf16(y[0], y[1]); o.y = pk_bf16(y[2], y[3]); *(u32x2*)(dst16 + lane * 4 + i * 256) = o; }
    }
}

__device__ __forceinline__ void transpose_tile(const float* W, int N, int k0, int n0, bf16_t* Wt, int ldt, int nout0, int kout0, float* tile) {
    const int tid = threadIdx.x;
#pragma unroll
    for (int i = 0; i < 8; ++i) { const int k = i * 8 + (tid >> 6), n = tid & 63; tile[k * 65 + n] = W[(size_t)(k0 + k) * N + n0 + n]; }
    __syncthreads();
#pragma unroll
    for (int i = 0; i < 8; ++i) { const int n = i * 8 + (tid >> 6), k = tid & 63; Wt[(size_t)(nout0 + n) * ldt + kout0 + k] = f2bf(tile[k * 65 + n]); }
    __syncthreads();
}

__device__ void phase_prep(const Params& p, unsigned char* smem) {
    const int tid = threadIdx.x, lane = tid & 63, wid = tid >> 6;
    const int gw = blockIdx.x * NWAVES + wid, nw = gridDim.x * NWAVES;
    const size_t gtid = (size_t)blockIdx.x * NTHREADS + tid, nthr = (size_t)gridDim.x * NTHREADS;
    bf16_t* h0b = (bf16_t*)(p.ws + WS_H0B);
    for (int r = gw; r < T_; r += nw) ln_row(p.x + (size_t)r * D_, p.ln0_g, p.ln0_b, nullptr, h0b + (size_t)r * D_, lane);
    {
        const size_t n4 = (size_t)16384 * 1024 / 4;
        u32x2* ub = (u32x2*)(p.ws + WS_UB); u32x2* vb = (u32x2*)(p.ws + WS_VB);
        for (size_t i = gtid; i < n4; i += nthr) {
            const f32x4 a = ((const f32x4*)p.pu)[i]; u32x2 o; o.x = pk_bf16(a[0], a[1]); o.y = pk_bf16(a[2], a[3]); ub[i] = o;
            const f32x4 c = ((const f32x4*)p.pv)[i]; u32x2 o2; o2.x = pk_bf16(c[0], c[1]); o2.y = pk_bf16(c[2], c[3]); vb[i] = o2;
        }
        u32x2* sk = (u32x2*)(p.ws + WS_SUBK);
        for (size_t i = gtid; i < 2 * 128 * 128 / 4; i += nthr) { const f32x4 a = ((const f32x4*)p.subk)[i]; u32x2 o; o.x = pk_bf16(a[0], a[1]); o.y = pk_bf16(a[2], a[3]); sk[i] = o; }
        bf16_t* pw = (bf16_t*)(p.ws + WS_POOLW);
        for (size_t i = gtid; i < 2 * 2 * 128 * 128; i += nthr) {
            const int half = (int)(i >> 15), blk = (int)((i >> 14) & 1), r = (int)((i >> 7) & 127), c = (int)(i & 127);
            pw[(size_t)half * 65536 + (size_t)(blk * 128 + r) * 256 + ((1 - blk) * 128 + c)] = 0;
        }
    }
    float* tile = (float*)smem;
    constexpr int T_IN = 16 * 32, T_OUT = 16 * 16, T_Q = 16 * 32, T_POOL = 16;
    for (int it = blockIdx.x; it < T_IN + T_OUT + T_Q + T_POOL; it += gridDim.x) {
        if (it < T_IN) { const int kt = it >> 5, nt = it & 31; transpose_tile(p.w_in, 2048, kt * 64, nt * 64, (bf16_t*)(p.ws + WS_WIN), 1024, nt * 64, kt * 64, tile); }
        else if (it < T_IN + T_OUT) { const int j = it - T_IN, kt = j >> 4, nt = j & 15; transpose_tile(p.w_out, 1024, kt * 64, nt * 64, (bf16_t*)(p.ws + WS_WOUT), 1024, nt * 64, kt * 64, tile); }
        else if (it < T_IN + T_OUT + T_Q) { const int j = it - T_IN - T_OUT, kt = j >> 5, nt = j & 31; transpose_tile(p.wq, 2048, kt * 64, nt * 64, (bf16_t*)(p.ws + WS_WQ), 1024, nt * 64, kt * 64, tile); }
        else { const int j = it - T_IN - T_OUT - T_Q, g = j >> 2, kt = (j >> 1) & 1, nt = j & 1, half = g >> 1, gg = g & 1;
            transpose_tile(p.pool_w + (size_t)g * 128 * 128, 128, kt * 64, nt * 64, (bf16_t*)(p.ws + WS_POOLW) + (size_t)half * 65536, 256, gg * 128 + nt * 64, gg * 128 + kt * 64, tile); }
    }
}

constexpr int BM = 128, BN = 256, BK = 64, LDT = 72;
constexpr int GEMM_LDS_BYTES = (BM + BN) * LDT * 2;

template <class Epi>
__device__ void gemm_phase(const bf16_t* A, int lda, long strideA, const bf16_t* Bt, int ldb, long strideB, int M, int N, int K, int nbatch, const Epi& epi, unsigned char* smem) {
    bf16_t* As = (bf16_t*)smem; bf16_t* Bs = As + BM * LDT;
    const int tid = threadIdx.x, lane = tid & 63, wid = tid >> 6, wr = wid >> 2, wc = wid & 3, fr = lane & 15, fq = lane >> 4;
    const int ntm = M / BM, ntn = N / BN, tiles_per = ntm * ntn, total = tiles_per * nbatch, nk = K / BK;
    const int lrow = tid >> 3, lch = tid & 7;
    for (int tile = blockIdx.x; tile < total; tile += gridDim.x) {
        const int bz = tile / tiles_per, tt = tile - bz * tiles_per, tm = tt / ntn, tn = tt - tm * ntn;
        const bf16_t* Ab = A + (size_t)bz * strideA + (size_t)(tm * BM + lrow) * lda + lch * 8;
        const bf16_t* Bb = Bt + (size_t)bz * strideB + (size_t)(tn * BN + lrow) * ldb + lch * 8;
        u32x4 ra[2], rb[4];
#pragma unroll
        for (int i = 0; i < 2; ++i) ra[i] = *(const u32x4*)(Ab + (size_t)(64 * i) * lda);
#pragma unroll
        for (int i = 0; i < 4; ++i) rb[i] = *(const u32x4*)(Bb + (size_t)(64 * i) * ldb);
        f32x4 acc[4][4];
#pragma unroll
        for (int m = 0; m < 4; ++m)
#pragma unroll
            for (int n = 0; n < 4; ++n) acc[m][n] = (f32x4){0.f, 0.f, 0.f, 0.f};
        for (int kt = 0; kt < nk; ++kt) {
            __syncthreads();
#pragma unroll
            for (int i = 0; i < 2; ++i) *(u32x4*)(As + (lrow + 64 * i) * LDT + lch * 8) = ra[i];
#pragma unroll
            for (int i = 0; i < 4; ++i) *(u32x4*)(Bs + (lrow + 64 * i) * LDT + lch * 8) = rb[i];
            __syncthreads();
            if (kt + 1 < nk) {
#pragma unroll
                for (int i = 0; i < 2; ++i) ra[i] = *(const u32x4*)(Ab + (size_t)(64 * i) * lda + (kt + 1) * BK);
#pragma unroll
                for (int i = 0; i < 4; ++i) rb[i] = *(const u32x4*)(Bb + (size_t)(64 * i) * ldb + (kt + 1) * BK);
            }
#pragma unroll
            for (int ks = 0; ks < 2; ++ks) {
                bf16x8 af[4], bfr[4];
#pragma unroll
                for (int m = 0; m < 4; ++m) af[m] = *(const bf16x8*)(As + (wr * 64 + m * 16 + fr) * LDT + ks * 32 + fq * 8);
#pragma unroll
                for (int n = 0; n < 4; ++n) bfr[n] = *(const bf16x8*)(Bs + (wc * 64 + n * 16 + fr) * LDT + ks * 32 + fq * 8);
#pragma unroll
                for (int m = 0; m < 4; ++m)
#pragma unroll
                    for (int n = 0; n < 4; ++n) acc[m][n] = __builtin_amdgcn_mfma_f32_16x16x32_bf16(bfr[n], af[m], acc[m][n], 0, 0, 0);
            }
        }
#pragma unroll
        for (int m = 0; m < 4; ++m)
#pragma unroll
            for (int n = 0; n < 4; ++n) epi(bz, tm * BM + wr * 64 + m * 16 + fr, tn * BN + wc * 64 + n * 16 + fq * 4, acc[m][n]);
    }
}

struct EpiGemm1 {
    bf16_t* hcat; bf16_t* vT;
    __device__ __forceinline__ void operator()(int, int row, int col, f32x4 v) const {
        if (col < 1536) { u32x2 o; o.x = pk_bf16(v[0], v[1]); o.y = pk_bf16(v[2], v[3]); *(u32x2*)(hcat + (size_t)row * 1536 + col) = o; }
        else {
            const int c = col - 1536, hh = c >> 6, d = c & 63, b = row >> 11, s = row & 2047;
            bf16_t* dst = vT + ((size_t)((b * 8 + hh) * 64 + d)) * 2048 + s;
#pragma unroll
            for (int j = 0; j < 4; ++j) dst[(size_t)j * 2048] = f2bf(v[j]);
        }
    }
};
struct EpiPool {
    bf16_t* mix; const float* pb; const float* ps;
    __device__ __forceinline__ void operator()(int bz, int row, int col, f32x4 v) const {
        const int gc = bz * 256 + col;
        const f32x4 b = *(const f32x4*)(pb + gc), s = *(const f32x4*)(ps + gc);
        const f32x4 y = (v + b) * s;
        u32x2 o; o.x = pk_bf16(y[0], y[1]); o.y = pk_bf16(y[2], y[3]); *(u32x2*)(mix + (size_t)row * 1024 + gc) = o;
    }
};
struct EpiGemm2 {
    const bf16_t* h0b; float* y1;
    __device__ __forceinline__ void operator()(int, int row, int col, f32x4 v) const {
        const u32x2 h = *(const u32x2*)(h0b + (size_t)row * 1024 + col);
        f32x4 y; y[0] = DN_ALPHA * bf_lo(h.x) + v[0]; y[1] = DN_ALPHA * bf_hi(h.x) + v[1]; y[2] = DN_ALPHA * bf_lo(h.y) + v[2]; y[3] = DN_ALPHA * bf_hi(h.y) + v[3];
        *(f32x4*)(y1 + (size_t)row * 1024 + col) = y;
    }
};
struct EpiBf16 {
    bf16_t* C; int ldc;
    __device__ __forceinline__ void operator()(int, int row, int col, f32x4 v) const {
        u32x2 o; o.x = pk_bf16(v[0], v[1]); o.y = pk_bf16(v[2], v[3]); *(u32x2*)(C + (size_t)row * ldc + col) = o;
    }
};

__device__ void phase_attn(const Params& p) {
    const bf16_t* hcat = (const bf16_t*)(p.ws + WS_HCAT); const bf16_t* vT = (const bf16_t*)(p.ws + WS_VT); bf16_t* mix = (bf16_t*)(p.ws + WS_MIX);
    const int tid = threadIdx.x, lane = tid & 63, wid = tid >> 6, qi = lane & 31, hf = lane >> 5;
    const int gw = blockIdx.x * NWAVES + wid, nw = gridDim.x * NWAVES;
    for (int item = gw; item < 4096; item += nw) {
        const int qt = item & 63, bh = item >> 6, b = bh >> 3, h = bh & 7;
        const int q0 = qt * 32, t = q0 + qi; const size_t tb = (size_t)b * 2048;
        bf16x8 qf[4];
        { const bf16_t* qrow = hcat + (tb + t) * 1536 + 512 + h * 64 + hf * 8;
#pragma unroll
          for (int s = 0; s < 4; ++s) qf[s] = *(const bf16x8*)(qrow + s * 16); }
        f32x16 o0, o1;
#pragma unroll
        for (int r = 0; r < 16; ++r) { o0[r] = 0.f; o1[r] = 0.f; }
        float R = 0.f;
        const bf16_t* vbase = vT + (size_t)(bh * 64 + qi) * 2048 + 4 * hf;
        for (int k0 = q0; k0 >= 0; k0 -= 32) {
            bf16x8 kf[4];
            { const bf16_t* krow = hcat + (tb + k0 + qi) * 1536 + 1024 + h * 64 + hf * 8;
#pragma unroll
              for (int s = 0; s < 4; ++s) kf[s] = *(const bf16x8*)(krow + s * 16); }
            bf16x8 vf[2][2];
#pragma unroll
            for (int db = 0; db < 2; ++db)
#pragma unroll
                for (int s = 0; s < 2; ++s) {
                    const bf16_t* vr = vbase + (size_t)(db * 32) * 2048 + k0 + 16 * s;
                    const u32x2 lo = *(const u32x2*)vr, hi = *(const u32x2*)(vr + 8);
                    u32x4 w; w.x = lo.x; w.y = lo.y; w.z = hi.x; w.w = hi.y;
                    vf[db][s] = __builtin_bit_cast(bf16x8, w);
                }
            f32x16 sacc;
#pragma unroll
            for (int r = 0; r < 16; ++r) sacc[r] = 0.f;
#pragma unroll
            for (int s = 0; s < 4; ++s) sacc = __builtin_amdgcn_mfma_f32_32x32x16_bf16(kf[s], qf[s], sacc, 0, 0, 0);
            float zv[16], sfx[16], tot[4], ptot[4], after[4];
            const bool diag = (k0 == q0);
#pragma unroll
            for (int r = 0; r < 16; ++r) {
                const float z = sacc[r] * 0.125f;
                const int kk = k0 + (r & 3) + 8 * (r >> 2) + 4 * hf;
                const bool valid = !diag || (kk < t);
                const float sp = fmaxf(z, 0.f) + __logf(1.f + __expf(-fabsf(z)));
                zv[r] = z; sfx[r] = valid ? -sp : 0.f;
            }
#pragma unroll
            for (int g = 0; g < 4; ++g) {
                sfx[4 * g + 2] += sfx[4 * g + 3]; sfx[4 * g + 1] += sfx[4 * g + 2]; sfx[4 * g] += sfx[4 * g + 1];
                tot[g] = sfx[4 * g];
            }
#pragma unroll
            for (int g = 0; g < 4; ++g) ptot[g] = __shfl_xor(tot[g], 32);
            float run = 0.f;
#pragma unroll
            for (int g = 3; g >= 0; --g) { after[g] = run + (hf == 0 ? ptot[g] : 0.f); run += tot[g] + ptot[g]; }
            unsigned apk[8];
#pragma unroll
            for (int r = 0; r < 16; r += 2) {
                float a0, a1;
                { const int kk = k0 + (r & 3) + 8 * (r >> 2) + 4 * hf; const bool valid = !diag || (kk < t);
                  const float e = __expf(zv[r] + sfx[r] + after[r >> 2] + R); a0 = valid ? e : 0.f; }
                { const int r1 = r + 1; const int kk = k0 + (r1 & 3) + 8 * (r1 >> 2) + 4 * hf; const bool valid = !diag || (kk < t);
                  const float e = __expf(zv[r1] + sfx[r1] + after[r1 >> 2] + R); a1 = valid ? e : 0.f; }
                apk[r >> 1] = pk_bf16(a0, a1);
            }
            R += run;
            u32x4 w0, w1; w0.x = apk[0]; w0.y = apk[1]; w0.z = apk[2]; w0.w = apk[3]; w1.x = apk[4]; w1.y = apk[5]; w1.z = apk[6]; w1.w = apk[7];
            const bf16x8 af0 = __builtin_bit_cast(bf16x8, w0), af1 = __builtin_bit_cast(bf16x8, w1);
            o0 = __builtin_amdgcn_mfma_f32_32x32x16_bf16(vf[0][0], af0, o0, 0, 0, 0);
            o0 = __builtin_amdgcn_mfma_f32_32x32x16_bf16(vf[0][1], af1, o0, 0, 0, 0);
            o1 = __builtin_amdgcn_mfma_f32_32x32x16_bf16(vf[1][0], af0, o1, 0, 0, 0);
            o1 = __builtin_amdgcn_mfma_f32_32x32x16_bf16(vf[1][1], af1, o1, 0, 0, 0);
            if (__all(R <= -88.0f)) break;
        }
        bf16_t* orow = mix + (tb + t) * 1024 + 512 + h * 64 + 4 * hf;
#pragma unroll
        for (int g = 0; g < 4; ++g) {
            u32x2 w; w.x = pk_bf16(o0[4 * g], o0[4 * g + 1]); w.y = pk_bf16(o0[4 * g + 2], o0[4 * g + 3]); *(u32x2*)(orow + 8 * g) = w;
            u32x2 w2; w2.x = pk_bf16(o1[4 * g], o1[4 * g + 1]); w2.y = pk_bf16(o1[4 * g + 2], o1[4 * g + 3]); *(u32x2*)(orow + 32 + 8 * g) = w2;
        }
    }
}

__device__ void phase_poolprep(const Params& p) {
    const bf16_t* hcat = (const bf16_t*)(p.ws + WS_HCAT); bf16_t* pooled = (bf16_t*)(p.ws + WS_POOLED);
    const size_t gtid = (size_t)blockIdx.x * NTHREADS + threadIdx.x, nthr = (size_t)gridDim.x * NTHREADS;
    for (size_t it = gtid; it < (size_t)T_ * 64; it += nthr) {
        const int t = (int)(it >> 6), c8 = (int)(it & 63) * 8, g = c8 >> 7, w = 2 << g, s = t & 2047;
        const int cnt = (s + 1 < w) ? (s + 1) : w;
        float acc[8], cur[8];
#pragma unroll
        for (int j = 0; j < 8; ++j) acc[j] = 0.f;
        for (int i = 0; i < cnt; ++i) {
            const u32x4 v = *(const u32x4*)(hcat + (size_t)(t - i) * 1536 + c8);
            const float f[8] = {bf_lo(v.x), bf_hi(v.x), bf_lo(v.y), bf_hi(v.y), bf_lo(v.z), bf_hi(v.z), bf_lo(v.w), bf_hi(v.w)};
#pragma unroll
            for (int j = 0; j < 8; ++j) { acc[j] += f[j]; if (i == 0) cur[j] = f[j]; }
        }
        const float inv = 1.0f / (float)cnt;
        u32x4 o; o.x = pk_bf16(acc[0] * inv - cur[0], acc[1] * inv - cur[1]); o.y = pk_bf16(acc[2] * inv - cur[2], acc[3] * inv - cur[3]);
        o.z = pk_bf16(acc[4] * inv - cur[4], acc[5] * inv - cur[5]); o.w = pk_bf16(acc[6] * inv - cur[6], acc[7] * inv - cur[7]);
        *(u32x4*)(pooled + (size_t)t * 512 + c8) = o;
    }
}

__device__ void phase_ln1(const Params& p) {
    const int lane = threadIdx.x & 63, wid = threadIdx.x >> 6;
    const int gw = blockIdx.x * NWAVES + wid, nw = gridDim.x * NWAVES;
    bf16_t* x1b = (bf16_t*)(p.ws + WS_H0B);
    for (int r = gw; r < T_; r += nw) ln_row(p.out + (size_t)r * D_, p.ln1_g, p.ln1_b, p.out + (size_t)r * D_, x1b + (size_t)r * D_, lane);
}

__device__ __forceinline__ unsigned ord_key(float f) { const unsigned u = __float_as_uint(f); return u ^ ((unsigned)((int)u >> 31) | 0x80000000u); }
__device__ __forceinline__ float ord_val(unsigned k) { const unsigned u = (k & 0x80000000u) ? (k ^ 0x80000000u) : ~k; return __uint_as_float(u); }

__device__ void phase_topk(const Params& p) {
    const bf16_t* qp = (const bf16_t*)(p.ws + WS_HCAT); const bf16_t* subk = (const bf16_t*)(p.ws + WS_SUBK);
    int* idx = (int*)(p.ws + WS_MIX); float* gate = (float*)(p.ws + WS_MIX + 8 * MB); float* ginv = (float*)(p.ws + WS_MIX + 16 * MB);
    const int tid = threadIdx.x, lane = tid & 63, wid = tid >> 6, qi = lane & 31, hf = lane >> 5;
    const int gw = blockIdx.x * NWAVES + wid, nw = gridDim.x * NWAVES;
    for (int item = gw; item < 4096; item += nw) {
        const int R = item * 32 + qi;
        unsigned hf4 = (unsigned)hf << 2; asm volatile("" : "+v"(hf4));
        unsigned sel[2][16];
#pragma unroll
        for (int i = 0; i < 16; ++i) { sel[0][i] = 0u; sel[1][i] = 0u; }
#pragma unroll
        for (int pp = 0; pp < 2; ++pp) {
            bf16x8 qf[8];
            { const bf16_t* qrow = qp + (size_t)R * 256 + pp * 128 + hf * 8;
#pragma unroll
              for (int s = 0; s < 8; ++s) qf[s] = *(const bf16x8*)(qrow + s * 16); }
            unsigned keys[64];
#pragma unroll
            for (int nb = 0; nb < 4; ++nb) {
                f32x16 sc;
#pragma unroll
                for (int r = 0; r < 16; ++r) sc[r] = 0.f;
                const bf16_t* krow = subk + (size_t)pp * 16384 + (size_t)(nb * 32 + qi) * 128 + hf * 8;
#pragma unroll
                for (int s = 0; s < 8; ++s) { const bf16x8 kf = *(const bf16x8*)(krow + s * 16); sc = __builtin_amdgcn_mfma_f32_32x32x16_bf16(kf, qf[s], sc, 0, 0, 0); }
#pragma unroll
                for (int r = 0; r < 16; ++r) { const unsigned nbase = (unsigned)(nb * 32 + (r & 3) + 8 * (r >> 2)); keys[nb * 16 + r] = ((ord_key(sc[r]) & 0xFFFFFF80u) | (127u ^ nbase)) ^ hf4; }
                __builtin_amdgcn_sched_barrier(0);
            }
#pragma unroll 1
            for (int it = 0; it < 16; ++it) {
                unsigned m = keys[0];
#pragma unroll
                for (int i = 1; i < 64; ++i) m = max(m, keys[i]);
                const unsigned pm = (unsigned)__shfl_xor((int)m, 32); m = max(m, pm);
#pragma unroll
                for (int i = 15; i > 0; --i) sel[pp][i] = sel[pp][i - 1];
                sel[pp][0] = m;
#pragma unroll
                for (int i = 0; i < 64; ++i) keys[i] = (keys[i] == m) ? 0u : keys[i];
            }
            __builtin_amdgcn_sched_barrier(0);
        }
        float av[16], bv[16]; int an[16], bn[16];
#pragma unroll
        for (int i = 0; i < 16; ++i) { av[i] = ord_val(sel[0][15 - i] & 0xFFFFFF80u); an[i] = 127 - (int)(sel[0][15 - i] & 127u); bv[i] = ord_val(sel[1][15 - i] & 0xFFFFFF80u); bn[i] = 127 - (int)(sel[1][15 - i] & 127u); }
        unsigned ck[50];
#pragma unroll
        for (int i = 0; i < 16; ++i) { an[i] *= 128; }
        {
            int c = 0;
#pragma unroll
            for (int i = 0; i < 16; ++i)
#pragma unroll
                for (int j = 0; j < 16; ++j)
                    if ((i + 1) * (j + 1) <= 16) { const float s = av[i] + bv[j]; ck[c] = (ord_key(s) & 0xFFFFFF00u) | (unsigned)(255 - (i * 16 + j)); ++c; }
        }
        float s0 = 0.f, sum = 0.f;
#pragma unroll 1
        for (int it = 0; it < 16; ++it) {
#pragma unroll
            for (int i = 0; i < 16; ++i) { asm volatile("" : "+v"(av[i])); asm volatile("" : "+v"(bv[i])); asm volatile("" : "+v"(an[i])); asm volatile("" : "+v"(bn[i])); }
            unsigned m = ck[0];
#pragma unroll
            for (int c = 1; c < 50; ++c) m = max(m, ck[c]);
            float s = 0.f; int e = 0;
            {
                int c = 0;
#pragma unroll
                for (int i = 0; i < 16; ++i)
#pragma unroll
                    for (int j = 0; j < 16; ++j)
                        if ((i + 1) * (j + 1) <= 16) { const bool hit = (ck[c] == m); s = hit ? (av[i] + bv[j]) : s; e = hit ? (an[i] + bn[j]) : e; ck[c] = hit ? 0u : ck[c]; ++c; }
            }
            if (it == 0) s0 = s;
            const float ex = __expf(s - s0); sum += ex;
            if (hf == 0) { idx[(size_t)R * 16 + it] = e; gate[(size_t)R * 16 + it] = ex; }
        }
        if (hf == 0) ginv[R] = 1.0f / sum;
    }
}

__device__ __forceinline__ float dot16(const float (&x)[16], u32x4 a, u32x4 b) {
    float s = x[0] * bf_lo(a.x);
    s += x[1] * bf_hi(a.x); s += x[2] * bf_lo(a.y); s += x[3] * bf_hi(a.y); s += x[4] * bf_lo(a.z); s += x[5] * bf_hi(a.z); s += x[6] * bf_lo(a.w); s += x[7] * bf_hi(a.w);
    s += x[8] * bf_lo(b.x); s += x[9] * bf_hi(b.x); s += x[10] * bf_lo(b.y); s += x[11] * bf_hi(b.y); s += x[12] * bf_lo(b.z); s += x[13] * bf_hi(b.z); s += x[14] * bf_lo(b.w); s += x[15] * bf_hi(b.w);
    return s;
}
__device__ __forceinline__ void axpy16(float (&acc)[16], float a, u32x4 v0, u32x4 v1) {
    acc[0] += a * bf_lo(v0.x); acc[1] += a * bf_hi(v0.x); acc[2] += a * bf_lo(v0.y); acc[3] += a * bf_hi(v0.y); acc[4] += a * bf_lo(v0.z); acc[5] += a * bf_hi(v0.z); acc[6] += a * bf_lo(v0.w); acc[7] += a * bf_hi(v0.w);
    acc[8] += a * bf_lo(v1.x); acc[9] += a * bf_hi(v1.x); acc[10] += a * bf_lo(v1.y); acc[11] += a * bf_hi(v1.y); acc[12] += a * bf_lo(v1.z); acc[13] += a * bf_hi(v1.z); acc[14] += a * bf_lo(v1.w); acc[15] += a * bf_hi(v1.w);
}

__device__ void phase_gather(const Params& p) {
    const bf16_t* ub = (const bf16_t*)(p.ws + WS_UB); const bf16_t* vb = (const bf16_t*)(p.ws + WS_VB);
    const int* idx = (const int*)(p.ws + WS_MIX); const float* gate = (const float*)(p.ws + WS_MIX + 8 * MB); const float* ginv = (const float*)(p.ws + WS_MIX + 16 * MB);
    const int lane = threadIdx.x & 63, wid = threadIdx.x >> 6;
    const int gw = blockIdx.x * NWAVES + wid, nw = gridDim.x * NWAVES;
    for (int t = gw; t < T_; t += nw) {
        float x[16], acc[16];
        { const float* xr = p.out + (size_t)t * 1024 + 8 * lane;
          const f32x4 a = *(const f32x4*)xr, b = *(const f32x4*)(xr + 4), c = *(const f32x4*)(xr + 512), d = *(const f32x4*)(xr + 516);
#pragma unroll
          for (int j = 0; j < 4; ++j) { x[j] = a[j]; x[4 + j] = b[j]; x[8 + j] = c[j]; x[12 + j] = d[j]; } }
#pragma unroll
        for (int j = 0; j < 16; ++j) acc[j] = 0.f;
        const int e0 = idx[(size_t)t * 128 + lane], e1 = idx[(size_t)t * 128 + 64 + lane];
        const float g0 = gate[(size_t)t * 128 + lane] * ginv[(size_t)t * 8 + (lane >> 4)], g1 = gate[(size_t)t * 128 + 64 + lane] * ginv[(size_t)t * 8 + 4 + (lane >> 4)];
        for (int half = 0; half < 2; ++half) {
            const int es = half ? e1 : e0; const float gs = half ? g1 : g0;
            for (int kb = 0; kb < 64; kb += 8) {
                u32x4 ur[8][2], vr[8][2];
#pragma unroll
                for (int j = 0; j < 8; ++j) {
                    const int e = __builtin_amdgcn_readfirstlane(__shfl(es, kb + j));
                    const bf16_t* urow = ub + (size_t)e * 1024 + 8 * lane; const bf16_t* vrow = vb + (size_t)e * 1024 + 8 * lane;
                    ur[j][0] = *(const u32x4*)urow; ur[j][1] = *(const u32x4*)(urow + 512);
                    vr[j][0] = *(const u32x4*)vrow; vr[j][1] = *(const u32x4*)(vrow + 512);
                }
#pragma unroll
                for (int j = 0; j < 8; ++j) {
                    const float hid = wave_sum(dot16(x, ur[j][0], ur[j][1]));
                    const float gt = __shfl(gs, kb + j);
                    const float act = 0.5f * hid * (1.0f + erff(hid * 0.70710678118654752f)) * gt;
                    axpy16(acc, act, vr[j][0], vr[j][1]);
                }
            }
        }
        float y[16], s = 0.f;
#pragma unroll
        for (int j = 0; j < 16; ++j) { y[j] = DN_ALPHA * x[j] + acc[j]; s += y[j]; }
        const float mean = wave_sum(s) * (1.0f / 1024.0f);
        float q = 0.f;
#pragma unroll
        for (int j = 0; j < 16; ++j) { const float d = y[j] - mean; q += d * d; }
        const float rstd = rsqrtf(wave_sum(q) * (1.0f / 1024.0f) + LN_EPS);
        float* orow = p.out + (size_t)t * 1024 + 8 * lane;
#pragma unroll
        for (int c = 0; c < 4; ++c) {
            const int off = (c >> 1) * 512 + (c & 1) * 4;
            const f32x4 gg = *(const f32x4*)(p.ln2_g + 8 * lane + off), bb = *(const f32x4*)(p.ln2_b + 8 * lane + off);
            f32x4 o;
#pragma unroll
            for (int j = 0; j < 4; ++j) o[j] = (y[c * 4 + j] - mean) * rstd * gg[j] + bb[j];
            *(f32x4*)(orow + off) = o;
        }
    }
}

template <int PH>
__global__ void __launch_bounds__(NTHREADS) k_phase(Params p) {
    __shared__ __attribute__((aligned(16))) unsigned char smem[GEMM_LDS_BYTES];
    if (PH == 0) phase_prep(p, smem);
    if (PH == 1) { EpiGemm1 e{(bf16_t*)(p.ws + WS_HCAT), (bf16_t*)(p.ws + WS_VT)};
        gemm_phase((const bf16_t*)(p.ws + WS_H0B), 1024, 0, (const bf16_t*)(p.ws + WS_WIN), 1024, 0, T_, 2048, 1024, 1, e, smem); }
    if (PH == 2) { phase_attn(p); phase_poolprep(p); }
    if (PH == 3) { EpiPool e{(bf16_t*)(p.ws + WS_MIX), p.pool_b, p.pool_scale};
        gemm_phase((const bf16_t*)(p.ws + WS_POOLED), 512, 256, (const bf16_t*)(p.ws + WS_POOLW), 256, 65536, T_, 256, 256, 2, e, smem); }
    if (PH == 4) { EpiGemm2 e{(const bf16_t*)(p.ws + WS_H0B), p.out};
        gemm_phase((const bf16_t*)(p.ws + WS_MIX), 1024, 0, (const bf16_t*)(p.ws + WS_WOUT), 1024, 0, T_, 1024, 1024, 1, e, smem); }
    if (PH == 5) phase_ln1(p);
    if (PH == 6) { EpiBf16 e{(bf16_t*)(p.ws + WS_HCAT), 2048};
        gemm_phase((const bf16_t*)(p.ws + WS_H0B), 1024, 0, (const bf16_t*)(p.ws + WS_WQ), 1024, 0, T_, 2048, 1024, 1, e, smem); }
    if (PH == 7) phase_topk(p);
    if (PH == 8) phase_gather(p);
}

extern "C" void kernel_launch(void* const* d_in, const int* in_sizes, int n_in, void* d_out, int out_size, void* d_ws, size_t ws_size, hipStream_t stream) {
    if (n_in != 16 || out_size != T_ * D_ || ws_size < WS_END) {
        fprintf(stderr, "kernel_launch: unexpected problem (n_in %d, out %d, ws %zu < %zu)\n", n_in, out_size, ws_size, (size_t)WS_END);
        return;
    }
    Params p{};
    p.x = (const float*)d_in[0]; p.ln0_g = (const float*)d_in[1]; p.ln0_b = (const float*)d_in[2]; p.w_in = (const float*)d_in[3];
    p.pool_w = (const float*)d_in[4]; p.pool_b = (const float*)d_in[5]; p.pool_scale = (const float*)d_in[6]; p.w_out = (const float*)d_in[7];
    p.ln1_g = (const float*)d_in[8]; p.ln1_b = (const float*)d_in[9]; p.wq = (const float*)d_in[10]; p.subk = (const float*)d_in[11];
    p.pu = (const float*)d_in[12]; p.pv = (const float*)d_in[13]; p.ln2_g = (const float*)d_in[14]; p.ln2_b = (const float*)d_in[15];
    p.out = (float*)d_out; p.ws = (unsigned char*)d_ws;
    const dim3 grid(256), block(NTHREADS);
    k_phase<0><<<grid, block, 0, stream>>>(p);
    k_phase<1><<<grid, block, 0, stream>>>(p);
    k_phase<2><<<grid, block, 0, stream>>>(p);
    k_phase<3><<<grid, block, 0, stream>>>(p);
    k_phase<4><<<grid, block, 0, stream>>>(p);
    k_phase<5><<<grid, block, 0, stream>>>(p);
    k_phase<6><<<grid, block, 0, stream>>>(p);
    k_phase<7><<<grid, block, 0, stream>>>(p);
    k_phase<8><<<grid, block, 0, stream>>>(p);
}
```

```cpp
#include <hip/hip_runtime.h>
#include <hip/hip_cooperative_groups.h>
#include <cstdio>
#include <cstdint>

namespace cg = cooperative_groups;

typedef unsigned short bf16_t;
typedef short bf16x8 __attribute__((ext_vector_type(8)));
typedef float f32x4 __attribute__((ext_vector_type(4)));
typedef float f32x16 __attribute__((ext_vector_type(16)));
typedef unsigned u32x4 __attribute__((ext_vector_type(4)));
typedef unsigned u32x2 __attribute__((ext_vector_type(2)));

constexpr int T_ = 16384, D_ = 1024, S_ = 2048;
constexpr int NTHREADS = 512, NWAVES = 8;
constexpr float LN_EPS = 1e-5f;
constexpr float DN_ALPHA = 1.189207115002721f;

constexpr size_t MB = 1024 * 1024;
constexpr size_t WS_CTL = 0;
constexpr size_t WS_H0B = 64 * 1024;
constexpr size_t WS_WIN = WS_H0B + 32 * MB;
constexpr size_t WS_WOUT = WS_WIN + 4 * MB;
constexpr size_t WS_WQ = WS_WOUT + 2 * MB;
constexpr size_t WS_POOLW = WS_WQ + 4 * MB;
constexpr size_t WS_SUBK = WS_POOLW + 256 * 1024;
constexpr size_t WS_UB = WS_SUBK + 64 * 1024;
constexpr size_t WS_U8 = WS_UB, WS_V8 = WS_UB + 16 * MB;
constexpr size_t WS_VB = WS_UB + 32 * MB;
constexpr size_t WS_SU = WS_VB, WS_SV = WS_VB + 64 * 1024;
constexpr size_t WS_HCAT = WS_VB + 32 * MB;
constexpr size_t WS_VT = WS_HCAT + 48 * MB;
constexpr size_t WS_MIX = WS_VT + 16 * MB;
constexpr size_t WS_POOLED = WS_MIX + 32 * MB;
constexpr size_t WS_END = WS_POOLED + 16 * MB;

struct Params {
    const float *x, *ln0_g, *ln0_b, *w_in, *pool_w, *pool_b, *pool_scale, *w_out, *ln1_g, *ln1_b, *wq, *subk, *pu, *pv, *ln2_g, *ln2_b;
    float* out;
    unsigned char* ws;
};

typedef float f32x2 __attribute__((ext_vector_type(2)));
typedef __bf16 bf16x2n __attribute__((ext_vector_type(2)));
__device__ __forceinline__ unsigned pk_bf16(float lo, float hi) { const f32x2 v = {lo, hi}; return __builtin_bit_cast(unsigned, __builtin_convertvector(v, bf16x2n)); }
__device__ __forceinline__ bf16_t f2bf(float f) { return (bf16_t)(pk_bf16(f, 0.f) & 0xffffu); }
__device__ __forceinline__ float bf_lo(unsigned u) { return __uint_as_float(u << 16); }
__device__ __forceinline__ float bf_hi(unsigned u) { return __uint_as_float(u & 0xffff0000u); }
template <int CTRL> __device__ __forceinline__ float dpp_f(float x) { return __int_as_float(__builtin_amdgcn_update_dpp(0, __float_as_int(x), CTRL, 0xF, 0xF, true)); }
__device__ __forceinline__ float row_sum16(float x) { x += dpp_f<0x128>(x); x += dpp_f<0x124>(x); x += dpp_f<0x122>(x); x += dpp_f<0x121>(x); return x; }
__device__ __forceinline__ float swap16_add(float a, float b) { const auto q = __builtin_amdgcn_permlane16_swap(__float_as_uint(a), __float_as_uint(b), false, false); return __uint_as_float(q[0]) + __uint_as_float(q[1]); }
__device__ __forceinline__ float swap32_add(float a, float b) { const auto q = __builtin_amdgcn_permlane32_swap(__float_as_uint(a), __float_as_uint(b), false, false); return __uint_as_float(q[0]) + __uint_as_float(q[1]); }
__device__ __forceinline__ float wave_sum(float v) { v = row_sum16(v); v = swap16_add(v, v); return swap32_add(v, v); }

__device__ __forceinline__ void ln_row(const float* src, const float* g, const float* b, float* dst32, bf16_t* dst16, int lane) {
    f32x4 v[4];
    float s = 0.f;
#pragma unroll
    for (int i = 0; i < 4; ++i) { v[i] = *(const f32x4*)(src + lane * 4 + i * 256); s += (v[i][0] + v[i][1]) + (v[i][2] + v[i][3]); }
    const float mean = wave_sum(s) * (1.0f / 1024.0f);
    float q = 0.f;
#pragma unroll
    for (int i = 0; i < 4; ++i) { f32x4 d = v[i] - mean; q += (d[0] * d[0] + d[1] * d[1]) + (d[2] * d[2] + d[3] * d[3]); }
    const float rstd = rsqrtf(wave_sum(q) * (1.0f / 1024.0f) + LN_EPS);
#pragma unroll
    for (int i = 0; i < 4; ++i) {
        const f32x4 gg = *(const f32x4*)(g + lane * 4 + i * 256), bb = *(const f32x4*)(b + lane * 4 + i * 256);
        const f32x4 y = (v[i] - mean) * rstd * gg + bb;
        if (dst32) *(f32x4*)(dst32 + lane * 4 + i * 256) = y;
        if (dst16) { u32x2 o; o.x = pk_bf16(y[0], y[1]); o.y = pk_bf16(y[2], y[3]); *(u32x2*)(dst16 + lane * 4 + i * 256) = o; }
    }
}

__device__ __forceinline__ void ln_rows4(const float* src, size_t rstride, const float* g, const float* b, bf16_t* dst16, int lane) {
    f32x4 v[4][4];
#pragma unroll
    for (int j = 0; j < 4; ++j)
#pragma unroll
        for (int i = 0; i < 4; ++i) v[j][i] = *(const f32x4*)(src + j * rstride + lane * 4 + i * 256);
    f32x4 gg[4], bb[4];
#pragma unroll
    for (int i = 0; i < 4; ++i) { gg[i] = *(const f32x4*)(g + lane * 4 + i * 256); bb[i] = *(const f32x4*)(b + lane * 4 + i * 256); }
#pragma unroll
    for (int j = 0; j < 4; ++j) {
        float s = 0.f;
#pragma unroll
        for (int i = 0; i < 4; ++i) s += (v[j][i][0] + v[j][i][1]) + (v[j][i][2] + v[j][i][3]);
        const float mean = wave_sum(s) * (1.0f / 1024.0f);
        float q = 0.f;
#pragma unroll
        for (int i = 0; i < 4; ++i) { const f32x4 d = v[j][i] - mean; q += (d[0] * d[0] + d[1] * d[1]) + (d[2] * d[2] + d[3] * d[3]); }
        const float rstd = rsqrtf(wave_sum(q) * (1.0f / 1024.0f) + LN_EPS);
#pragma unroll
        for (int i = 0; i < 4; ++i) {
            const f32x4 y = (v[j][i] - mean) * rstd * gg[i] + bb[i];
            u32x2 o; o.x = pk_bf16(y[0], y[1]); o.y = pk_bf16(y[2], y[3]); *(u32x2*)(dst16 + j * rstride + lane * 4 + i * 256) = o;
        }
    }
}

__device__ __forceinline__ void transpose_tile_wave(const float* W, int N, int k0, int n0, bf16_t* Wt, int ldt, int nout0, int kout0, float* tile  , int lane) {
    float v[64];
#pragma unroll
    for (int k = 0; k < 64; ++k) v[k] = W[(size_t)(k0 + k) * N + n0 + lane];
#pragma unroll
    for (int k = 0; k < 64; ++k) tile[k * 65 + lane] = v[k];
    asm volatile("s_waitcnt lgkmcnt(0)" ::: "memory");
#pragma unroll
    for (int n = 0; n < 64; ++n) Wt[(size_t)(nout0 + n) * ldt + kout0 + lane] = f2bf(tile[lane * 65 + n]);
    asm volatile("s_waitcnt lgkmcnt(0)" ::: "memory");
}

__device__ __forceinline__ unsigned q8x4(float a, float b, float c, float d) {
    unsigned w = 0;
    w = __builtin_amdgcn_cvt_pk_u8_f32(__builtin_rintf(a) + 128.f, 0, w); w = __builtin_amdgcn_cvt_pk_u8_f32(__builtin_rintf(b) + 128.f, 1, w);
    w = __builtin_amdgcn_cvt_pk_u8_f32(__builtin_rintf(c) + 128.f, 2, w); w = __builtin_amdgcn_cvt_pk_u8_f32(__builtin_rintf(d) + 128.f, 3, w);
    return w ^ 0x80808080u;
}
__device__ __forceinline__ void convert_table_rows4(const Params& p, int r0, int lane) {
    const int tbl = r0 >> 14, row0 = r0 & 16383;
    const float* src = (tbl ? p.pv : p.pu) + (size_t)row0 * 1024 + 16 * lane;
    f32x4 v[4][4];
#pragma unroll
    for (int j = 0; j < 4; ++j)
#pragma unroll
        for (int i = 0; i < 4; ++i) v[j][i] = *(const f32x4*)(src + (size_t)j * 1024 + 4 * i);
#pragma unroll
    for (int j = 0; j < 4; ++j) {
        float amax = 0.f;
#pragma unroll
        for (int i = 0; i < 4; ++i) amax = fmaxf(amax, fmaxf(fmaxf(fabsf(v[j][i][0]), fabsf(v[j][i][1])), fmaxf(fabsf(v[j][i][2]), fabsf(v[j][i][3]))));
#pragma unroll
        for (int o = 32; o > 0; o >>= 1) amax = fmaxf(amax, __shfl_xor(amax, o));
        const float top = tbl ? 416.0f : 127.0f;
        const float sc = amax > 0.f ? top / amax : 1.0f, inv = amax > 0.f ? amax / top : 1.0f;
        u32x4 w;
        if (tbl) {
#pragma unroll
            for (int i = 0; i < 4; ++i) { int t = __builtin_amdgcn_cvt_pk_fp8_f32(v[j][i][0] * sc, v[j][i][1] * sc, 0, false); t = __builtin_amdgcn_cvt_pk_fp8_f32(v[j][i][2] * sc, v[j][i][3] * sc, t, true); w[i] = (unsigned)t; }
        } else {
#pragma unroll
            for (int i = 0; i < 4; ++i) w[i] = q8x4(v[j][i][0] * sc, v[j][i][1] * sc, v[j][i][2] * sc, v[j][i][3] * sc);
        }
        *(u32x4*)(p.ws + (tbl ? WS_V8 : WS_U8) + (size_t)(row0 + j) * 1024 + 16 * lane) = w;
        if (lane == 0) ((float*)(p.ws + (tbl ? WS_SV : WS_SU)))[row0 + j] = inv;
    }
}

__device__ void phase_prep(const Params& p, unsigned char* smem) {
    const int tid = threadIdx.x, lane = tid & 63, wid = tid >> 6;
    const int gw = blockIdx.x * NWAVES + wid, nw = gridDim.x * NWAVES;
    const size_t gtid = (size_t)blockIdx.x * NTHREADS + tid, nthr = (size_t)gridDim.x * NTHREADS;
    bf16_t* h0b = (bf16_t*)(p.ws + WS_H0B);
    for (int r = gw; r + 3 * nw < T_; r += 4 * nw) ln_rows4(p.x + (size_t)r * D_, (size_t)nw * D_, p.ln0_g, p.ln0_b, h0b + (size_t)r * D_, lane);
    if (T_ % (4 * nw) != 0) for (int r = gw + (T_ / (4 * nw)) * 4 * nw; r < T_; r += nw) ln_row(p.x + (size_t)r * D_, p.ln0_g, p.ln0_b, nullptr, h0b + (size_t)r * D_, lane);
    {
        u32x2* sk = (u32x2*)(p.ws + WS_SUBK);
        for (size_t i = gtid; i < 2 * 128 * 128 / 4; i += nthr) { const f32x4 a = ((const f32x4*)p.subk)[i]; u32x2 o; o.x = pk_bf16(a[0], a[1]); o.y = pk_bf16(a[2], a[3]); sk[i] = o; }
        bf16_t* pw = (bf16_t*)(p.ws + WS_POOLW);
        for (size_t i = gtid; i < 2 * 2 * 128 * 128; i += nthr) {
            const int half = (int)(i >> 15), blk = (int)((i >> 14) & 1), r = (int)((i >> 7) & 127), c = (int)(i & 127);
            pw[(size_t)half * 65536 + (size_t)(blk * 128 + r) * 256 + ((1 - blk) * 128 + c)] = 0;
        }
    }
    float* tile = (float*)smem + wid * (64 * 65);
    constexpr int T_IN = 16 * 32, T_OUT = 16 * 16, T_Q = 16 * 32, T_POOL = 16;
    for (int it = gw; it < T_IN + T_OUT + T_Q + T_POOL; it += nw) {
        if (it < T_IN) { const int kt = it >> 5, nt = it & 31; transpose_tile_wave(p.w_in, 2048, kt * 64, nt * 64, (bf16_t*)(p.ws + WS_WIN), 1024, nt * 64, kt * 64, tile, lane); }
        else if (it < T_IN + T_OUT) { const int j = it - T_IN, kt = j >> 4, nt = j & 15; transpose_tile_wave(p.w_out, 1024, kt * 64, nt * 64, (bf16_t*)(p.ws + WS_WOUT), 1024, nt * 64, kt * 64, tile, lane); }
        else if (it < T_IN + T_OUT + T_Q) { const int j = it - T_IN - T_OUT, kt = j >> 5, nt = j & 31; transpose_tile_wave(p.wq, 2048, kt * 64, nt * 64, (bf16_t*)(p.ws + WS_WQ), 1024, nt * 64, kt * 64, tile, lane); }
        else { const int j = it - T_IN - T_OUT - T_Q, g = j >> 2, kt = (j >> 1) & 1, nt = j & 1, half = g >> 1, gg = g & 1;
            transpose_tile_wave(p.pool_w + (size_t)g * 128 * 128, 128, kt * 64, nt * 64, (bf16_t*)(p.ws + WS_POOLW) + (size_t)half * 65536, 256, gg * 128 + nt * 64, gg * 128 + kt * 64, tile, lane); }
    }
}

constexpr int BM = 128, BN = 256, BK = 64, LDT = 72;
constexpr int GEMM_LDS_BYTES = (BM + BN) * LDT * 2;

template <class Epi>
__device__ void gemm_phase(const bf16_t* A, int lda, long strideA, const bf16_t* Bt, int ldb, long strideB, int M, int N, int K, int nbatch, const Epi& epi, unsigned char* smem) {
    bf16_t* As = (bf16_t*)smem; bf16_t* Bs = As + BM * LDT;
    const int tid = threadIdx.x, lane = tid & 63, wid = tid >> 6, wr = wid >> 2, wc = wid & 3, fr = lane & 15, fq = lane >> 4;
    const int ntm = M / BM, ntn = N / BN, tiles_per = ntm * ntn, total = tiles_per * nbatch, nk = K / BK;
    const int lrow = tid >> 3, lch = tid & 7;
    for (int tile = blockIdx.x; tile < total; tile += gridDim.x) {
        const int bz = tile / tiles_per, tt = tile - bz * tiles_per, tm = tt / ntn, tn = tt - tm * ntn;
        const bf16_t* Ab = A + (size_t)bz * strideA + (size_t)(tm * BM + lrow) * lda + lch * 8;
        const bf16_t* Bb = Bt + (size_t)bz * strideB + (size_t)(tn * BN + lrow) * ldb + lch * 8;
        u32x4 ra[2], rb[4];
#pragma unroll
        for (int i = 0; i < 2; ++i) ra[i] = *(const u32x4*)(Ab + (size_t)(64 * i) * lda);
#pragma unroll
        for (int i = 0; i < 4; ++i) rb[i] = *(const u32x4*)(Bb + (size_t)(64 * i) * ldb);
        f32x4 acc[4][4];
#pragma unroll
        for (int m = 0; m < 4; ++m)
#pragma unroll
            for (int n = 0; n < 4; ++n) acc[m][n] = (f32x4){0.f, 0.f, 0.f, 0.f};
        for (int kt = 0; kt < nk; ++kt) {
            __syncthreads();
#pragma unroll
            for (int i = 0; i < 2; ++i) *(u32x4*)(As + (lrow + 64 * i) * LDT + lch * 8) = ra[i];
#pragma unroll
            for (int i = 0; i < 4; ++i) *(u32x4*)(Bs + (lrow + 64 * i) * LDT + lch * 8) = rb[i];
            __syncthreads();
            if (kt + 1 < nk) {
#pragma unroll
                for (int i = 0; i < 2; ++i) ra[i] = *(const u32x4*)(Ab + (size_t)(64 * i) * lda + (kt + 1) * BK);
#pragma unroll
                for (int i = 0; i < 4; ++i) rb[i] = *(const u32x4*)(Bb + (size_t)(64 * i) * ldb + (kt + 1) * BK);
            }
#pragma unroll
            for (int ks = 0; ks < 2; ++ks) {
                bf16x8 af[4], bfr[4];
#pragma unroll
                for (int m = 0; m < 4; ++m) af[m] = *(const bf16x8*)(As + (wr * 64 + m * 16 + fr) * LDT + ks * 32 + fq * 8);
#pragma unroll
                for (int n = 0; n < 4; ++n) bfr[n] = *(const bf16x8*)(Bs + (wc * 64 + n * 16 + fr) * LDT + ks * 32 + fq * 8);
#pragma unroll
                for (int m = 0; m < 4; ++m)
#pragma unroll
                    for (int n = 0; n < 4; ++n) acc[m][n] = __builtin_amdgcn_mfma_f32_16x16x32_bf16(bfr[n], af[m], acc[m][n], 0, 0, 0);
            }
        }
#pragma unroll
        for (int m = 0; m < 4; ++m)
#pragma unroll
            for (int n = 0; n < 4; ++n) epi(bz, tm * BM + wr * 64 + m * 16 + fr, tn * BN + wc * 64 + n * 16 + fq * 4, acc[m][n]);
    }
}

struct EpiPool {
    bf16_t* mix; const float* pb; const float* ps;
    __device__ __forceinline__ void operator()(int bz, int row, int col, f32x4 v) const {
        const int gc = bz * 256 + col;
        const f32x4 b = *(const f32x4*)(pb + gc), s = *(const f32x4*)(ps + gc);
        const f32x4 y = (v + b) * s;
        u32x2 o; o.x = pk_bf16(y[0], y[1]); o.y = pk_bf16(y[2], y[3]); *(u32x2*)(mix + (size_t)row * 1024 + gc) = o;
    }
};
namespace pg8 {
#define PG8_LAS __attribute__((address_space(3)))
constexpr int BM = 256, BK = 64, HALF = 128, HTB = HALF * BK * 2  , STAGE_BYTES = 8 * HTB, NXCD = 8, WGM = 8;
__host__ __device__ __forceinline__ int lds_byte(int r, int c) { const int st = (r >> 4) * 2 + (c >> 5), rr = r & 15, cc = c & 31, ob = rr * 64 + cc * 2; return st * 1024 + (ob ^ (((ob >> 9) & 1) << 5)); }
__host__ __device__ __forceinline__ void stage_rc(int b, int& R, int& C) { const int st = b / 1024, sb = b % 1024, swz = sb ^ (((sb >> 9) & 1) << 5); R = (st >> 1) * 16 + swz / 64; C = (st & 1) * 32 + (swz % 64) / 2; }
__host__ __device__ __forceinline__ int perm32(int rho) { const int n = rho >> 4, i = rho & 15; return 8 * (i >> 2) + 4 * n + (i & 3); }
struct Unit { int pm, pn; };
struct Gemm { const bf16_t* A; const bf16_t* Bt; int M, N, K; };
struct StaticOrder {
    int nM, nN, nwg, G, c;
    __host__ __device__ void init(int M, int N, int G_, int c_) { nM = M / BM; nN = N / BM; nwg = nM * nN; G = G_; c = c_; }
    __host__ __device__ bool next(int i, Unit& u) const {
        const long L = (long)i * G + c; if (L >= nwg) return false;
        int wgid = (int)L; { const int q = nwg / NXCD, r = nwg % NXCD, xcd = wgid % NXCD, off = wgid / NXCD; wgid = (xcd < r ? xcd * (q + 1) : r * (q + 1) + (xcd - r) * q) + off; }
        const int nig = WGM * nN, gid = wgid / nig, fm = gid * WGM, gsz = (nM - fm) < WGM ? (nM - fm) : WGM;
        u.pm = fm + ((wgid % nig) % gsz); u.pn = (wgid % nig) / gsz; return true;
    }
    __device__ __forceinline__ void a_ready(const Unit&) const {}
    __device__ __forceinline__ void done(const Unit&) const {}
};
template <class Epi, class Sched>
__device__ __forceinline__ void gemm_phase(PG8_LAS unsigned char* lds, const Gemm g, const Sched& S, const Epi& E) {
    const int tid = threadIdx.x, wid = __builtin_amdgcn_readfirstlane(tid >> 6), lane = tid & 63, wr = wid >> 2, wc = wid & 3, fr = lane & 15, fq = lane >> 4;
    const int K = g.K, nt = K / BK;
    unsigned voffA[2], voffB[2];
#pragma unroll
    for (int i = 0; i < 2; ++i) { int R, C; stage_rc(tid * 16 + i * 8192, R, C); const int Rb = Epi::PERM ? ((R & ~31) + perm32(R & 31)) : R;
        voffA[i] = (unsigned)(R * K + C) * 2u; voffB[i] = (unsigned)(Rb * K + C) * 2u; }
    const size_t kstep = (size_t)(BK * 2);
    const size_t hstep = (size_t)HALF * K * 2;
    const size_t tstep = 2 * hstep;
    const unsigned ldsw = (unsigned)wid * 1024u;
    const int aoff = lds_byte(wr * 64 + fr, fq * 8), boff = lds_byte(wc * 32 + fr, fq * 8);
#define PG8_SA(b, h) (((b) * 2 + (h)) * HTB)
#define PG8_SB(b, h) ((4 + (b) * 2 + (h)) * HTB)
#define PG8_STAGE(bufoff, gbase, voff) do { _Pragma("unroll") for (int _i = 0; _i < 2; ++_i) \
        __builtin_amdgcn_global_load_lds((const unsigned*)((const char*)(gbase) + (voff)[_i]), (PG8_LAS unsigned*)(lds + (bufoff) + ldsw + _i * 8192), 16, 0, 0); } while (0)
#define PG8_LDA(dst, b, h) do { _Pragma("unroll") for (int m = 0; m < 4; ++m) _Pragma("unroll") for (int k = 0; k < 2; ++k) dst[m][k] = *(const PG8_LAS bf16x8*)(lds + PG8_SA(b, h) + aoff + m * 2048 + k * 1024); } while (0)
#define PG8_LDB(dst, b, h) do { _Pragma("unroll") for (int n = 0; n < 2; ++n) _Pragma("unroll") for (int k = 0; k < 2; ++k) dst[n][k] = *(const PG8_LAS bf16x8*)(lds + PG8_SB(b, h) + boff + n * 2048 + k * 1024); } while (0)
#define PG8_MMA(ai, bj, At, Bt) do { __builtin_amdgcn_s_setprio(1); _Pragma("unroll") for (int m = 0; m < 4; ++m) _Pragma("unroll") for (int n = 0; n < 2; ++n) _Pragma("unroll") for (int k = 0; k < 2; ++k) \
        acc[ai][bj][m][n] = __builtin_amdgcn_mfma_f32_16x16x32_bf16(Bt[n][k], At[m][k], acc[ai][bj][m][n], 0, 0, 0); __builtin_amdgcn_s_setprio(0); } while (0)
#define PG8_WAIT_V(n) asm volatile("s_waitcnt vmcnt(" #n ")" ::: "memory")
#define PG8_WAIT_L(n) asm volatile("s_waitcnt lgkmcnt(" #n ")" ::: "memory")
#define PG8_BAR __builtin_amdgcn_s_barrier()
#define PG8_SCHED __builtin_amdgcn_sched_barrier(0)
    Unit cur, nxt; int ui = 0;
    if (!S.next(0, cur)) return;
    f32x4 acc[2][2][4][2];
#pragma unroll
    for (int a = 0; a < 2; ++a)
#pragma unroll
        for (int b = 0; b < 2; ++b)
#pragma unroll
            for (int m = 0; m < 4; ++m)
#pragma unroll
                for (int n = 0; n < 2; ++n) acc[a][b][m][n] = (f32x4){0.f, 0.f, 0.f, 0.f};
    bf16x8 At[4][2], B0[2][2], B1[2][2];
    const char* cA = (const char*)g.A + (size_t)cur.pm * tstep; const char* cB = (const char*)g.Bt + (size_t)cur.pn * tstep;
    S.a_ready(cur);
    PG8_STAGE(PG8_SB(0, 0), cB, voffB); PG8_STAGE(PG8_SA(0, 0), cA, voffA); PG8_STAGE(PG8_SB(0, 1), cB + hstep, voffB); PG8_STAGE(PG8_SA(0, 1), cA + hstep, voffA);
    if (wr == 1) PG8_BAR;
    PG8_WAIT_V(4); PG8_BAR;
    PG8_STAGE(PG8_SB(1, 0), cB + kstep, voffB); PG8_STAGE(PG8_SA(1, 0), cA + kstep, voffA); PG8_STAGE(PG8_SB(1, 1), cB + hstep + kstep, voffB);
    PG8_WAIT_V(6); PG8_BAR;
    for (;;) {
        const bool has_next = S.next(ui + 1, nxt);
        const char* nA = has_next ? (const char*)g.A + (size_t)nxt.pm * tstep : cA; const char* nB = has_next ? (const char*)g.Bt + (size_t)nxt.pn * tstep : cB;
        for (int t = 0; t < nt; t += 2) {
            const bool last = (t == nt - 2);
            const char* a1 = cA + (size_t)(t + 1) * kstep;
            const char* a2 = last ? nA : cA + (size_t)(t + 2) * kstep; const char* b2 = last ? nB : cB + (size_t)(t + 2) * kstep;
            const char* a3 = a2 + kstep; const char* b3 = b2 + kstep;
            if (last && has_next) S.a_ready(nxt);
            PG8_LDB(B0, 0, 0); PG8_SCHED; PG8_LDA(At, 0, 0); PG8_STAGE(PG8_SA(1, 1), a1 + hstep, voffA);
            PG8_WAIT_L(8); PG8_BAR; PG8_WAIT_L(0); PG8_MMA(0, 0, At, B0); PG8_BAR; PG8_SCHED;
            PG8_LDB(B1, 0, 1); PG8_STAGE(PG8_SB(0, 0), b2, voffB);
            PG8_BAR; PG8_WAIT_L(0); PG8_MMA(0, 1, At, B1); PG8_BAR;
            PG8_LDA(At, 0, 1); PG8_STAGE(PG8_SA(0, 0), a2, voffA);
            PG8_BAR; PG8_WAIT_L(0); PG8_MMA(1, 0, At, B0); PG8_BAR; PG8_SCHED;
            PG8_STAGE(PG8_SB(0, 1), b2 + hstep, voffB);
            PG8_WAIT_V(6); PG8_BAR; PG8_MMA(1, 1, At, B1); PG8_BAR;
            PG8_LDB(B0, 1, 0); PG8_SCHED; PG8_LDA(At, 1, 0); PG8_STAGE(PG8_SA(0, 1), a2 + hstep, voffA);
            PG8_WAIT_L(8); PG8_BAR; PG8_WAIT_L(0); PG8_MMA(0, 0, At, B0); PG8_BAR; PG8_SCHED;
            PG8_LDB(B1, 1, 1); PG8_STAGE(PG8_SB(1, 0), b3, voffB);
            PG8_BAR; PG8_WAIT_L(0); PG8_MMA(0, 1, At, B1); PG8_BAR;
            PG8_LDA(At, 1, 1); PG8_STAGE(PG8_SA(1, 0), a3, voffA);
            PG8_BAR; PG8_WAIT_L(0); PG8_MMA(1, 0, At, B0); PG8_BAR; PG8_SCHED;
            PG8_STAGE(PG8_SB(1, 1), b3 + hstep, voffB);
            PG8_WAIT_V(6); PG8_BAR; PG8_MMA(1, 1, At, B1); PG8_BAR;
        }
        E(acc, cur, wr, wc, fr, fq); S.done(cur);
        if (!has_next) break;
#pragma unroll
        for (int a = 0; a < 2; ++a)
#pragma unroll
            for (int b = 0; b < 2; ++b)
#pragma unroll
                for (int m = 0; m < 4; ++m)
#pragma unroll
                    for (int n = 0; n < 2; ++n) acc[a][b][m][n] = (f32x4){0.f, 0.f, 0.f, 0.f};
        cur = nxt; cA = nA; cB = nB; ++ui;
    }
    PG8_WAIT_V(0);
    if (wr == 0) PG8_BAR;
    PG8_BAR;
#undef PG8_SA
#undef PG8_SB
#undef PG8_STAGE
#undef PG8_LDA
#undef PG8_LDB
#undef PG8_MMA
#undef PG8_WAIT_V
#undef PG8_WAIT_L
#undef PG8_BAR
#undef PG8_SCHED
}
}

struct EpiG1 {
    static constexpr bool PERM = true, AFTER_DRAIN = false;
    bf16_t* hcat; bf16_t* vT;
    __device__ __forceinline__ void operator()(const f32x4 (&acc)[2][2][4][2], const pg8::Unit& u, int wr, int wc, int fr, int fq) const {
        const int row0 = u.pm * 256 + wr * 64 + fr, col0 = u.pn * 256 + wc * 32 + 8 * fq;
#pragma unroll
        for (int ai = 0; ai < 2; ++ai)
#pragma unroll
            for (int m = 0; m < 4; ++m) {
                const int row = row0 + ai * 128 + m * 16;
#pragma unroll
                for (int bj = 0; bj < 2; ++bj) {
                    const int col = col0 + bj * 128; const f32x4 v0 = acc[ai][bj][m][0], v1 = acc[ai][bj][m][1];
                    if (u.pn < 6) { u32x4 w; w.x = pk_bf16(v0[0], v0[1]); w.y = pk_bf16(v0[2], v0[3]); w.z = pk_bf16(v1[0], v1[1]); w.w = pk_bf16(v1[2], v1[3]); *(u32x4*)(hcat + (size_t)row * 1536 + col) = w; }
                    else {
                        const int c = col - 1536, hh = c >> 6, d = c & 63, b = row >> 11, s = row & 2047;
                        bf16_t* dst = vT + ((size_t)((b * 8 + hh) * 64 + d)) * 2048 + s;
#pragma unroll
                        for (int j = 0; j < 4; ++j) { dst[(size_t)j * 2048] = f2bf(v0[j]); dst[(size_t)(4 + j) * 2048] = f2bf(v1[j]); }
                    }
                }
            }
    }
};
struct EpiG2 {
    static constexpr bool PERM = true, AFTER_DRAIN = false;
    const bf16_t* h0b; bf16_t* y1;
    __device__ __forceinline__ void operator()(const f32x4 (&acc)[2][2][4][2], const pg8::Unit& u, int wr, int wc, int fr, int fq) const {
        const int row0 = u.pm * 256 + wr * 64 + fr, col0 = u.pn * 256 + wc * 32 + 8 * fq;
#pragma unroll
        for (int ai = 0; ai < 2; ++ai)
#pragma unroll
            for (int m = 0; m < 4; ++m) {
                const int row = row0 + ai * 128 + m * 16;
#pragma unroll
                for (int bj = 0; bj < 2; ++bj) {
                    const int col = col0 + bj * 128; const f32x4 v0 = acc[ai][bj][m][0], v1 = acc[ai][bj][m][1];
                    const u32x4 h = *(const u32x4*)(h0b + (size_t)row * 1024 + col);
                    u32x4 w;
                    w.x = pk_bf16(DN_ALPHA * bf_lo(h.x) + v0[0], DN_ALPHA * bf_hi(h.x) + v0[1]); w.y = pk_bf16(DN_ALPHA * bf_lo(h.y) + v0[2], DN_ALPHA * bf_hi(h.y) + v0[3]);
                    w.z = pk_bf16(DN_ALPHA * bf_lo(h.z) + v1[0], DN_ALPHA * bf_hi(h.z) + v1[1]); w.w = pk_bf16(DN_ALPHA * bf_lo(h.w) + v1[2], DN_ALPHA * bf_hi(h.w) + v1[3]);
                    *(u32x4*)(y1 + (size_t)row * 1024 + col) = w;
                }
            }
    }
};
struct EpiG3 {
    static constexpr bool PERM = true, AFTER_DRAIN = false;
    bf16_t* C; int ldc;
    __device__ __forceinline__ void operator()(const f32x4 (&acc)[2][2][4][2], const pg8::Unit& u, int wr, int wc, int fr, int fq) const {
        const int row0 = u.pm * 256 + wr * 64 + fr, col0 = u.pn * 256 + wc * 32 + 8 * fq;
#pragma unroll
        for (int ai = 0; ai < 2; ++ai)
#pragma unroll
            for (int m = 0; m < 4; ++m) {
                const int row = row0 + ai * 128 + m * 16;
#pragma unroll
                for (int bj = 0; bj < 2; ++bj) {
                    const int col = col0 + bj * 128; const f32x4 v0 = acc[ai][bj][m][0], v1 = acc[ai][bj][m][1];
                    u32x4 w; w.x = pk_bf16(v0[0], v0[1]); w.y = pk_bf16(v0[2], v0[3]); w.z = pk_bf16(v1[0], v1[1]); w.w = pk_bf16(v1[2], v1[3]);
                    *(u32x4*)(C + (size_t)row * ldc + col) = w;
                }
            }
    }
};

constexpr int ATT_HIST = 160, ATT_KEYS = 256 + ATT_HIST, ATT_KSTR = 72  , ATT_VSTR = ATT_KEYS + 8  ;
constexpr int ATT_K_BYTES = ATT_KEYS * ATT_KSTR * 2, ATT_LDS_BYTES = ATT_K_BYTES + 64 * ATT_VSTR * 2;
__device__ void phase_attn(const Params& p, unsigned char* smem) {
    const bf16_t* hcat = (const bf16_t*)(p.ws + WS_HCAT); const bf16_t* vT = (const bf16_t*)(p.ws + WS_VT); bf16_t* mix = (bf16_t*)(p.ws + WS_MIX);
    const int tid = threadIdx.x, lane = tid & 63, wid = tid >> 6, qi = lane & 31, hf = lane >> 5;
    bf16_t* Ks = (bf16_t*)smem; bf16_t* Vs = (bf16_t*)(smem + ATT_K_BYTES);
    for (int item = blockIdx.x; item < 512; item += gridDim.x) {
        const int c = item & 7, bh = item >> 3, b = bh >> 3, h = bh & 7;
        const int q0c = c * 256, lo = (q0c > ATT_HIST) ? q0c - ATT_HIST : 0, nkeys = q0c + 256 - lo;
        const size_t tb = (size_t)b * 2048;
        const int q0 = q0c + wid * 32, t = q0 + qi;
        bf16x8 qf[4];
        { const bf16_t* qrow = hcat + (tb + t) * 1536 + 512 + h * 64 + hf * 8;
#pragma unroll
          for (int s = 0; s < 4; ++s) qf[s] = *(const bf16x8*)(qrow + s * 16); }
        __syncthreads();
        {
            const int cpr = nkeys >> 3;
            u32x4 rk[7], rv[7];
#pragma unroll
            for (int j = 0; j < 7; ++j) { const int i = tid + NTHREADS * j; const int ic = (i < nkeys * 8) ? i : 0; const int key = ic >> 3, ch = ic & 7;
                rk[j] = *(const u32x4*)(hcat + (tb + lo + key) * 1536 + 1024 + h * 64 + ch * 8);
                const int d = ic / cpr, cv = ic - d * cpr;
                rv[j] = *(const u32x4*)(vT + (size_t)(bh * 64 + d) * 2048 + lo + cv * 8); }
#pragma unroll
            for (int j = 0; j < 7; ++j) { const int i = tid + NTHREADS * j; if (i < nkeys * 8) { const int key = i >> 3, ch = i & 7; *(u32x4*)(Ks + key * ATT_KSTR + ch * 8) = rk[j];
                const int d = i / cpr, cv = i - d * cpr; *(u32x4*)(Vs + d * ATT_VSTR + cv * 8) = rv[j]; } }
        }
        __syncthreads();
        f32x16 o0, o1;
#pragma unroll
        for (int r = 0; r < 16; ++r) { o0[r] = 0.f; o1[r] = 0.f; }
        float R = 0.f;
        const bf16_t* vbase = vT + (size_t)(bh * 64 + qi) * 2048 + 4 * hf;
        for (int k0 = q0; k0 >= 0; k0 -= 32) {
            bf16x8 kf[4], vf[2][2];
            if (k0 >= lo) {
                const int kl = k0 - lo;
                const bf16_t* kr = Ks + (kl + qi) * ATT_KSTR + hf * 8;
#pragma unroll
                for (int s = 0; s < 4; ++s) kf[s] = *(const bf16x8*)(kr + s * 16);
#pragma unroll
                for (int db = 0; db < 2; ++db)
#pragma unroll
                    for (int s = 0; s < 2; ++s) { const bf16_t* vr = Vs + (db * 32 + qi) * ATT_VSTR + kl + 16 * s + 4 * hf;
                        const u32x2 l = *(const u32x2*)vr, hh = *(const u32x2*)(vr + 8); u32x4 w; w.x = l.x; w.y = l.y; w.z = hh.x; w.w = hh.y; vf[db][s] = __builtin_bit_cast(bf16x8, w); }
            } else {
                const bf16_t* krow = hcat + (tb + k0 + qi) * 1536 + 1024 + h * 64 + hf * 8;
#pragma unroll
                for (int s = 0; s < 4; ++s) kf[s] = *(const bf16x8*)(krow + s * 16);
#pragma unroll
                for (int db = 0; db < 2; ++db)
#pragma unroll
                    for (int s = 0; s < 2; ++s) { const bf16_t* vr = vbase + (size_t)(db * 32) * 2048 + k0 + 16 * s;
                        const u32x2 l = *(const u32x2*)vr, hh = *(const u32x2*)(vr + 8); u32x4 w; w.x = l.x; w.y = l.y; w.z = hh.x; w.w = hh.y; vf[db][s] = __builtin_bit_cast(bf16x8, w); }
            }
            f32x16 sacc;
#pragma unroll
            for (int r = 0; r < 16; ++r) sacc[r] = 0.f;
#pragma unroll
            for (int s = 0; s < 4; ++s) sacc = __builtin_amdgcn_mfma_f32_32x32x16_bf16(kf[s], qf[s], sacc, 0, 0, 0);
            float zv[16], sfx[16], tot[4], ptot[4], after[4];
            const bool diag = (k0 == q0);
            unsigned vmask = 0xffffu;
            if (diag) { vmask = 0u;
#pragma unroll
                for (int r = 0; r < 16; ++r) vmask |= ((k0 + (r & 3) + 8 * (r >> 2) + 4 * hf) < t) ? (1u << r) : 0u; }
#pragma unroll
            for (int r = 0; r < 16; ++r) {
                const float z2 = sacc[r] * (0.125f * 1.44269504088896341f);
                const float sp2 = fmaxf(z2, 0.f) + __builtin_amdgcn_logf(1.f + __builtin_amdgcn_exp2f(-fabsf(z2)));
                zv[r] = z2; sfx[r] = (vmask >> r) & 1u ? -sp2 : 0.f;
            }
#pragma unroll
            for (int g = 0; g < 4; ++g) {
                sfx[4 * g + 2] += sfx[4 * g + 3]; sfx[4 * g + 1] += sfx[4 * g + 2]; sfx[4 * g] += sfx[4 * g + 1];
                tot[g] = sfx[4 * g];
            }
#pragma unroll
            for (int g = 0; g < 4; ++g) ptot[g] = __shfl_xor(tot[g], 32);
            float run = 0.f;
#pragma unroll
            for (int g = 3; g >= 0; --g) { after[g] = run + (hf == 0 ? ptot[g] : 0.f); run += tot[g] + ptot[g]; }
            unsigned apk[8];
#pragma unroll
            for (int r = 0; r < 16; r += 2) {
                const float e0 = __builtin_amdgcn_exp2f(zv[r] + sfx[r] + (after[r >> 2] + R)), e1 = __builtin_amdgcn_exp2f(zv[r + 1] + sfx[r + 1] + (after[(r + 1) >> 2] + R));
                apk[r >> 1] = pk_bf16((vmask >> r) & 1u ? e0 : 0.f, (vmask >> (r + 1)) & 1u ? e1 : 0.f);
            }
            R += run;
            u32x4 w0, w1; w0.x = apk[0]; w0.y = apk[1]; w0.z = apk[2]; w0.w = apk[3]; w1.x = apk[4]; w1.y = apk[5]; w1.z = apk[6]; w1.w = apk[7];
            const bf16x8 af0 = __builtin_bit_cast(bf16x8, w0), af1 = __builtin_bit_cast(bf16x8, w1);
            o0 = __builtin_amdgcn_mfma_f32_32x32x16_bf16(vf[0][0], af0, o0, 0, 0, 0);
            o0 = __builtin_amdgcn_mfma_f32_32x32x16_bf16(vf[0][1], af1, o0, 0, 0, 0);
            o1 = __builtin_amdgcn_mfma_f32_32x32x16_bf16(vf[1][0], af0, o1, 0, 0, 0);
            o1 = __builtin_amdgcn_mfma_f32_32x32x16_bf16(vf[1][1], af1, o1, 0, 0, 0);
            if (__all(R <= -127.0f)) break;
        }
        bf16_t* orow = mix + (tb + t) * 1024 + 512 + h * 64 + 4 * hf;
#pragma unroll
        for (int g = 0; g < 4; ++g) {
            u32x2 w; w.x = pk_bf16(o0[4 * g], o0[4 * g + 1]); w.y = pk_bf16(o0[4 * g + 2], o0[4 * g + 3]); *(u32x2*)(orow + 8 * g) = w;
            u32x2 w2; w2.x = pk_bf16(o1[4 * g], o1[4 * g + 1]); w2.y = pk_bf16(o1[4 * g + 2], o1[4 * g + 3]); *(u32x2*)(orow + 32 + 8 * g) = w2;
        }
    }
    __syncthreads();
}

template <int W> __device__ __forceinline__ void pool_item(const bf16_t* hcat, bf16_t* pooled, int t, int c8) {
    const int s = t & 2047, cnt = (s + 1 < W) ? (s + 1) : W;
    u32x4 v[W];
#pragma unroll
    for (int i = 0; i < W; ++i) { const int ti = t - ((i < cnt) ? i : (cnt - 1)); v[i] = *(const u32x4*)(hcat + (size_t)ti * 1536 + c8); }
    float acc[8];
#pragma unroll
    for (int j = 0; j < 8; ++j) acc[j] = 0.f;
#pragma unroll
    for (int i = 0; i < W; ++i) {
        const float wgt = (i < cnt) ? 1.f : 0.f;
        acc[0] += wgt * bf_lo(v[i].x); acc[1] += wgt * bf_hi(v[i].x); acc[2] += wgt * bf_lo(v[i].y); acc[3] += wgt * bf_hi(v[i].y);
        acc[4] += wgt * bf_lo(v[i].z); acc[5] += wgt * bf_hi(v[i].z); acc[6] += wgt * bf_lo(v[i].w); acc[7] += wgt * bf_hi(v[i].w);
    }
    const float inv = 1.0f / (float)cnt;
    u32x4 o; o.x = pk_bf16(acc[0] * inv - bf_lo(v[0].x), acc[1] * inv - bf_hi(v[0].x)); o.y = pk_bf16(acc[2] * inv - bf_lo(v[0].y), acc[3] * inv - bf_hi(v[0].y));
    o.z = pk_bf16(acc[4] * inv - bf_lo(v[0].z), acc[5] * inv - bf_hi(v[0].z)); o.w = pk_bf16(acc[6] * inv - bf_lo(v[0].w), acc[7] * inv - bf_hi(v[0].w));
    *(u32x4*)(pooled + (size_t)t * 512 + c8) = o;
}
__device__ void phase_poolprep(const Params& p) {
    const bf16_t* hcat = (const bf16_t*)(p.ws + WS_HCAT); bf16_t* pooled = (bf16_t*)(p.ws + WS_POOLED);
    const int lane = threadIdx.x & 63, wid = threadIdx.x >> 6;
    if (blockIdx.x >= 256) return;
    const int tm = blockIdx.x & 127, bz = blockIdx.x >> 7;
    for (int ii = wid; ii < 64; ii += NWAVES) {
        const int g = 2 * bz + (ii & 1), t = tm * 128 + (ii >> 1) * 4 + (lane >> 4), c8 = g * 128 + (lane & 15) * 8;
        if (g == 0) pool_item<2>(hcat, pooled, t, c8);
        else if (g == 1) pool_item<4>(hcat, pooled, t, c8);
        else if (g == 2) pool_item<8>(hcat, pooled, t, c8);
        else pool_item<16>(hcat, pooled, t, c8);
    }
}

__device__ void phase_ln1(const Params& p) {
    const int lane = threadIdx.x & 63, wid = threadIdx.x >> 6;
    const int gw = blockIdx.x * NWAVES + wid, nw = gridDim.x * NWAVES;
    const bf16_t* y1 = (const bf16_t*)(p.ws + WS_HCAT); bf16_t* x1b = (bf16_t*)(p.ws + WS_H0B);
    f32x4 gg[4], bb[4];
#pragma unroll
    for (int i = 0; i < 4; ++i) { gg[i] = *(const f32x4*)(p.ln1_g + 16 * lane + 4 * i); bb[i] = *(const f32x4*)(p.ln1_b + 16 * lane + 4 * i); }
    for (int r0 = gw; r0 < T_; r0 += 4 * nw) {
        u32x4 raw[4][2];
#pragma unroll
        for (int j = 0; j < 4; ++j) { const int r = min(r0 + j * nw, T_ - 1); raw[j][0] = *(const u32x4*)(y1 + (size_t)r * 1024 + 16 * lane); raw[j][1] = *(const u32x4*)(y1 + (size_t)r * 1024 + 16 * lane + 8); }
#pragma unroll
        for (int j = 0; j < 4; ++j) {
            const int r = r0 + j * nw; if (r >= T_) break;
            float v[16];
#pragma unroll
            for (int h = 0; h < 2; ++h) { v[8 * h] = bf_lo(raw[j][h].x); v[8 * h + 1] = bf_hi(raw[j][h].x); v[8 * h + 2] = bf_lo(raw[j][h].y); v[8 * h + 3] = bf_hi(raw[j][h].y);
                v[8 * h + 4] = bf_lo(raw[j][h].z); v[8 * h + 5] = bf_hi(raw[j][h].z); v[8 * h + 6] = bf_lo(raw[j][h].w); v[8 * h + 7] = bf_hi(raw[j][h].w); }
            float sm = 0.f;
#pragma unroll
            for (int i = 0; i < 16; ++i) sm += v[i];
            const float mean = wave_sum(sm) * (1.0f / 1024.0f);
            float q = 0.f;
#pragma unroll
            for (int i = 0; i < 16; ++i) { const float d = v[i] - mean; q += d * d; }
            const float rstd = rsqrtf(wave_sum(q) * (1.0f / 1024.0f) + LN_EPS);
            u32x4 o[2];
#pragma unroll
            for (int h = 0; h < 2; ++h) {
                float y[8];
#pragma unroll
                for (int i = 0; i < 8; ++i) y[i] = (v[8 * h + i] - mean) * rstd * gg[2 * h + (i >> 2)][i & 3] + bb[2 * h + (i >> 2)][i & 3];
                o[h].x = pk_bf16(y[0], y[1]); o[h].y = pk_bf16(y[2], y[3]); o[h].z = pk_bf16(y[4], y[5]); o[h].w = pk_bf16(y[6], y[7]);
            }
            *(u32x4*)(x1b + (size_t)r * 1024 + 16 * lane) = o[0]; *(u32x4*)(x1b + (size_t)r * 1024 + 16 * lane + 8) = o[1];
        }
    }
}

__device__ __forceinline__ unsigned ord_key(float f) { const unsigned u = __float_as_uint(f); return u ^ ((unsigned)((int)u >> 31) | 0x80000000u); }
__device__ __forceinline__ float ord_val(unsigned k) { const unsigned u = (k & 0x80000000u) ? (k ^ 0x80000000u) : ~k; return __uint_as_float(u); }

#define TK_CE(x, a, b) do { const unsigned hi_ = max((x)[a], (x)[b]), lo_ = min((x)[a], (x)[b]); (x)[a] = hi_; (x)[b] = lo_; } while (0)
template <int N> __device__ __forceinline__ void tk_merge_desc(unsigned (&x)[N]) {
#pragma unroll
    for (int k = N / 2; k >= 1; k >>= 1)
#pragma unroll
        for (int i = 0; i < N; ++i) if ((i & k) == 0) TK_CE(x, i, i | k);
}
template <int N> __device__ __forceinline__ void tk_sort_desc(unsigned (&x)[N]) {
#pragma unroll
    for (int sz = 2; sz <= N; sz <<= 1)
#pragma unroll
        for (int k = sz >> 1; k >= 1; k >>= 1)
#pragma unroll
            for (int i = 0; i < N; ++i) { const int l = i ^ k; if (l > i) { if ((i & sz) == 0) TK_CE(x, i, l); else TK_CE(x, l, i); } }
}
__device__ __forceinline__ void tk_top16(const unsigned (&a)[16], const unsigned (&b)[16], unsigned (&o)[16]) {
#pragma unroll
    for (int i = 0; i < 16; ++i) o[i] = max(a[i], b[15 - i]);
    tk_merge_desc<16>(o);
}

__device__ void phase_topk(const Params& p, unsigned char* smem) {
    const bf16_t* qp = (const bf16_t*)(p.ws + WS_HCAT); const bf16_t* subk = (const bf16_t*)(p.ws + WS_SUBK);
    int* idx = (int*)(p.ws + WS_MIX); float* gate = (float*)(p.ws + WS_MIX + 8 * MB); float* ginv = (float*)(p.ws + WS_MIX + 16 * MB);
    const int gw = blockIdx.x * NWAVES + ((int)threadIdx.x >> 6), nw = gridDim.x * NWAVES;
    constexpr int SK_STRIDE = 272, SK_BYTES = 256 * SK_STRIDE;
    {
        const int tid0 = threadIdx.x;
#pragma unroll
        for (int i = 0; i < 8; ++i) { const int c = tid0 + 512 * i, row = c >> 4, ch = c & 15;
            *(u32x4*)(smem + row * SK_STRIDE + ch * 16) = *(const u32x4*)(subk + (size_t)row * 128 + ch * 8); }
        __syncthreads();
    }
    for (int item = gw; item < 4096; item += nw) {
        int tid = threadIdx.x; asm volatile("" : "+v"(tid));
        const int lane = tid & 63, qi = lane & 31, hf = lane >> 5;
        const int R = item * 32 + qi;
        unsigned hf4 = (unsigned)hf << 2; asm volatile("" : "+v"(hf4));
        unsigned sel[2][16];
        bf16x8 qfa[2][8];
#pragma unroll
        for (int pp = 0; pp < 2; ++pp) { const bf16_t* qrow = qp + (size_t)R * 256 + pp * 128 + hf * 8;
#pragma unroll
            for (int s = 0; s < 8; ++s) qfa[pp][s] = *(const bf16x8*)(qrow + s * 16); }
#pragma unroll
        for (int pp = 0; pp < 2; ++pp) {
            bf16x8 qf[8];
#pragma unroll
            for (int s = 0; s < 8; ++s) qf[s] = qfa[pp][s];
            unsigned g[4][16];
#pragma unroll
            for (int nb = 0; nb < 4; ++nb) {
                f32x16 sc;
#pragma unroll
                for (int r = 0; r < 16; ++r) sc[r] = 0.f;
                const unsigned char* krow = smem + (pp * 128 + nb * 32 + qi) * SK_STRIDE + hf * 16;
#pragma unroll
                for (int s = 0; s < 8; ++s) { const bf16x8 kf = *(const bf16x8*)(krow + s * 32); sc = __builtin_amdgcn_mfma_f32_32x32x16_bf16(kf, qf[s], sc, 0, 0, 0); }
#pragma unroll
                for (int r = 0; r < 16; ++r) { const unsigned nbase = (unsigned)(nb * 32 + (r & 3) + 8 * (r >> 2)); g[nb][r] = ((ord_key(sc[r]) & 0xFFFFFF80u) | (127u ^ nbase)) ^ hf4; }
                tk_sort_desc<16>(g[nb]);
                __builtin_amdgcn_sched_barrier(0);
            }
            unsigned m01[16], m23[16], m[16], u[16];
            tk_top16(g[0], g[1], m01); tk_top16(g[2], g[3], m23); tk_top16(m01, m23, m);
#pragma unroll
            for (int i = 0; i < 16; ++i) u[i] = max(m[i], (unsigned)__shfl_xor((int)m[15 - i], 32));
            tk_merge_desc<16>(u);
#pragma unroll
            for (int i = 0; i < 16; ++i) sel[pp][i] = u[i];
            __builtin_amdgcn_sched_barrier(0);
        }
        float av[16], bv[16]; unsigned anb[4] = {0u, 0u, 0u, 0u}, bnb[4] = {0u, 0u, 0u, 0u};
#pragma unroll
        for (int i = 0; i < 16; ++i) { av[i] = ord_val(sel[0][i] & 0xFFFFFF80u); bv[i] = ord_val(sel[1][i] & 0xFFFFFF80u);
            anb[i >> 2] |= (127u - (sel[0][i] & 127u)) << (8 * (i & 3)); bnb[i >> 2] |= (127u - (sel[1][i] & 127u)) << (8 * (i & 3)); }
        unsigned char* tb = smem + SK_BYTES + (tid >> 6) * 2048 + lane * 32;
        *(u32x4*)tb = (u32x4){anb[0], anb[1], anb[2], anb[3]}; *(u32x4*)(tb + 16) = (u32x4){bnb[0], bnb[1], bnb[2], bnb[3]};
#define TK_CK(i, j) ((ord_key(av[i] + bv[j]) & 0xFFFFFF00u) | (unsigned)(255 - ((i) * 16 + (j))))
        unsigned cA[16], cB[16], cC[16], cD[16], m1[16], m2[16], best[16];
#pragma unroll
        for (int i = 0; i < 16; ++i) { cA[i] = TK_CK(i, 0); cB[i] = (i < 15) ? TK_CK(0, i + 1) : 0u; cD[i] = 0u; }
        cC[0] = TK_CK(1, 1); cC[1] = TK_CK(1, 2); cC[2] = TK_CK(1, 3); cC[3] = TK_CK(1, 4); cC[4] = TK_CK(1, 5); cC[5] = TK_CK(1, 6); cC[6] = TK_CK(1, 7);
        cC[7] = TK_CK(2, 1); cC[8] = TK_CK(2, 2); cC[9] = TK_CK(2, 3); cC[10] = TK_CK(2, 4);
        cC[11] = TK_CK(3, 1); cC[12] = TK_CK(3, 2); cC[13] = TK_CK(3, 3); cC[14] = TK_CK(4, 1); cC[15] = TK_CK(4, 2);
        cD[0] = TK_CK(5, 1); cD[1] = TK_CK(6, 1); cD[2] = TK_CK(7, 1);
#undef TK_CK
        tk_sort_desc<16>(cC);
        tk_top16(cA, cB, m1); tk_top16(cC, cD, m2); tk_top16(m1, m2, best);
        const float s0 = ord_val(best[0] & 0xFFFFFF00u);
        float ex[16], sum = 0.f; int eo[16];
#pragma unroll
        for (int k = 0; k < 16; ++k) {
            const unsigned pos = 255u - (best[k] & 255u);
            ex[k] = __expf(ord_val(best[k] & 0xFFFFFF00u) - s0); sum += ex[k];
            eo[k] = (int)tb[pos >> 4] * 128 + (int)tb[16 + (pos & 15)];
        }
        if (hf == 0) {
#pragma unroll
            for (int k = 0; k < 16; k += 4) {
                *(int4*)(idx + (size_t)R * 16 + k) = make_int4(eo[k], eo[k + 1], eo[k + 2], eo[k + 3]);
                *(f32x4*)(gate + (size_t)R * 16 + k) = (f32x4){ex[k], ex[k + 1], ex[k + 2], ex[k + 3]};
            }
            ginv[R] = 1.0f / sum;
        }
#pragma unroll 1
        for (int j = 0; j < 8; j += 4) convert_table_rows4(p, item * 8 + j, lane);
    }
}

typedef __bf16 bf16x2v __attribute__((ext_vector_type(2)));
constexpr int G2_XT_BYTES = 64 * 2048;
constexpr int G2_LIST_OFF = G2_XT_BYTES;
constexpr int G2_LDS_BYTES = G2_XT_BYTES + 8 * 1024 * 4;
constexpr size_t WS_ACT = WS_POOLED;
__device__ __forceinline__ unsigned g2_key(unsigned ent) { return ((ent >> 26) << 3) | ((ent >> 14) & 7u); }

__device__ __forceinline__ float gelu_as(float v) {
    const float av = fabsf(v), t = __builtin_amdgcn_rcpf(av * 0.2316418882f + 1.0f);
    float q = t * 0.5307027145f + (-0.7265760135f); q = q * t + 0.7107068705f; q = q * t + (-0.142248368f); q = q * t + 0.127414796f; q = q * t;
    const float e = __builtin_amdgcn_exp2f((v * v) * (-0.72134752044f));
    const float m = v * (q * e);
    return v < 0.f ? m : v - m;
}
__device__ __forceinline__ void g2u_issue(const unsigned char* u8, int entreg, int base, int lane, u32x4 (&ub)[8]) {
#pragma unroll
    for (int j = 0; j < 8; ++j) { const unsigned roff = (unsigned)__builtin_amdgcn_readlane(entreg, base + j) >> 7 & 0xfffffc00u;
        ub[j] = *(const u32x4*)(u8 + roff + 16 * lane); }
}
__device__ __forceinline__ float g2u_compute(const unsigned char* xw, int entreg, float sureg, float gsreg, int base, int lane, const u32x4 (&ub)[8]) {
    float s[8];
#pragma unroll
    for (int j = 0; j < 8; ++j) {
        const int slot = (__builtin_amdgcn_readlane(entreg, base + j) >> 14) & 7;
        const u32x4 x = *(const u32x4*)(xw + slot * 1024 + 16 * lane);
        int d = 0;
#pragma unroll
        for (int w = 0; w < 4; ++w) d = __builtin_amdgcn_sdot4((int)ub[j][w], (int)x[w], d, false);
        s[j] = (float)d;
    }
    const float q0 = swap16_add(swap32_add(s[0], s[4]), swap32_add(s[2], s[6]));
    const float q1 = swap16_add(swap32_add(s[1], s[5]), swap32_add(s[3], s[7]));
    const bool b3 = (lane & 8) != 0;
    const float keep = b3 ? q1 : q0, send = b3 ? q0 : q1;
    float r = keep + dpp_f<0x128>(send);
    r += dpp_f<0xB1>(r); r += dpp_f<0x4E>(r); r += dpp_f<0x141>(r);
    const float su = __shfl(sureg, base + (lane >> 3)), gs = __shfl(gsreg, base + (lane >> 3));
    const float hid = r * su;
    return gelu_as(hid) * gs;
}

__device__ __forceinline__ void g2v_issue(const unsigned char* vlane, int e, u32x4 (&vb)[8]) {
    const unsigned char* r = vlane + (size_t)e * 1024;
#pragma unroll
    for (int c = 0; c < 8; ++c) vb[c] = *(const u32x4*)(r + c * 128);
}
__device__ __forceinline__ void g2v_compute(f32x2 (&acc)[8][8], float a, const u32x4 (&vb)[8]) {
    const f32x2 a2 = {a, a};
#pragma unroll
    for (int c = 0; c < 8; ++c)
#pragma unroll
        for (int w = 0; w < 4; ++w) {
            const f32x2 lo = __builtin_amdgcn_cvt_pk_f32_fp8((int)vb[c][w], false), hi = __builtin_amdgcn_cvt_pk_f32_fp8((int)vb[c][w], true);
            asm("v_pk_fma_f32 %0, %1, %2, %0" : "+v"(acc[c][2 * w]) : "v"(a2), "v"(lo));
            asm("v_pk_fma_f32 %0, %1, %2, %0" : "+v"(acc[c][2 * w + 1]) : "v"(a2), "v"(hi));
        }
}

__device__ void phase_gather2(const Params& p, unsigned char* smem) {
    const unsigned char* u8 = p.ws + WS_U8; const unsigned char* v8 = p.ws + WS_V8;
    const float* su = (const float*)(p.ws + WS_SU); const float* sv = (const float*)(p.ws + WS_SV);
    const int* idx = (const int*)(p.ws + WS_MIX); const float* gate = (const float*)(p.ws + WS_MIX + 8 * MB); const float* ginv = (const float*)(p.ws + WS_MIX + 16 * MB);
    const bf16_t* x1b = (const bf16_t*)(p.ws + WS_H0B);
    const int wid = __builtin_amdgcn_readfirstlane((int)threadIdx.x >> 6);
    unsigned* lst = (unsigned*)(smem + G2_LIST_OFF) + wid * 1024;
    unsigned* cnt = (unsigned*)smem + wid * 1024;
    unsigned* bas = cnt + 256; unsigned* bas2 = cnt + 512;
    {
        const int tile = blockIdx.x; if (tile >= T_ / 64) return;
        const int tid = threadIdx.x, lane = tid & 63;
        const int tok0 = tile * 64, tw = tok0 + wid * 8;
        float* actw = (float*)(p.ws + WS_ACT) + (size_t)(tile * 8 + wid) * 2048;
        unsigned* expw = (unsigned*)(actw + 1024);
        __syncthreads();
        *(u32x4*)(cnt + 4 * lane) = (u32x4){0u, 0u, 0u, 0u};
        __syncthreads();
        {
            unsigned ent[16], rnk[16];
#pragma unroll
            for (int i = 0; i < 16; ++i) {
                const int slot = i >> 1, k = (i & 1) * 64 + lane;
                const unsigned e = (unsigned)idx[(size_t)(tw + slot) * 128 + k];
                ent[i] = (e << 17) | ((unsigned)slot << 14) | ((unsigned)k << 7);
                rnk[i] = atomicAdd(&cnt[g2_key(ent[i])], 1u);
            }
            __syncthreads();
            {
                const u32x4 c = *(const u32x4*)(cnt + 4 * lane);
                const unsigned tot = c.x + c.y + c.z + c.w; unsigned incl = tot;
#pragma unroll
                for (int o = 1; o < 64; o <<= 1) { const unsigned v = (unsigned)__shfl_up((int)incl, o); if (lane >= o) incl += v; }
                const unsigned ex = incl - tot;
                u32x4 b; b.x = ex; b.y = ex + c.x; b.z = ex + c.x + c.y; b.w = ex + c.x + c.y + c.z;
                *(u32x4*)(bas + 4 * lane) = b;
            }
            {
                const int sl = lane & 7, bg = lane >> 3;
                unsigned c[4], tot = 0;
#pragma unroll
                for (int q = 0; q < 4; ++q) { c[q] = cnt[(4 * bg + q) * 8 + sl]; tot += c[q]; }
                unsigned incl = tot;
#pragma unroll
                for (int o = 8; o < 64; o <<= 1) { const unsigned v = (unsigned)__shfl_up((int)incl, o); if (lane >= o) incl += v; }
                unsigned ex = incl - tot;
#pragma unroll
                for (int q = 0; q < 4; ++q) { bas2[(4 * bg + q) * 8 + sl] = ex; ex += c[q]; }
            }
            __syncthreads();
#pragma unroll
            for (int i = 0; i < 16; ++i) {
                const unsigned key = g2_key(ent[i]), r2 = bas2[key] + rnk[i], full = ent[i] | r2;
                lst[bas[key] + rnk[i]] = full;
                expw[(i >> 1) * 128 + r2] = ent[i] >> 17;
            }
        }
        __syncthreads();
        unsigned char* xwp = smem + wid * 8 * 1024;
        float* sxw = (float*)(smem + 64 * 1024) + wid * 8;
#pragma unroll 1
        for (int sl = 0; sl < 8; ++sl) {
            const bf16_t* xr = x1b + (size_t)(tw + sl) * 1024 + 16 * lane;
            const u32x4 a = *(const u32x4*)xr, b = *(const u32x4*)(xr + 8);
            const float v[16] = {bf_lo(a.x), bf_hi(a.x), bf_lo(a.y), bf_hi(a.y), bf_lo(a.z), bf_hi(a.z), bf_lo(a.w), bf_hi(a.w), bf_lo(b.x), bf_hi(b.x), bf_lo(b.y), bf_hi(b.y), bf_lo(b.z), bf_hi(b.z), bf_lo(b.w), bf_hi(b.w)};
            float amax = 0.f;
#pragma unroll
            for (int i = 0; i < 16; ++i) amax = fmaxf(amax, fabsf(v[i]));
#pragma unroll
            for (int o = 32; o > 0; o >>= 1) amax = fmaxf(amax, __shfl_xor(amax, o));
            const float sc = amax > 0.f ? 127.0f / amax : 1.0f;
            u32x4 w;
#pragma unroll
            for (int i = 0; i < 4; ++i) w[i] = q8x4(v[4 * i] * sc, v[4 * i + 1] * sc, v[4 * i + 2] * sc, v[4 * i + 3] * sc);
            *(u32x4*)(xwp + sl * 1024 + 16 * lane) = w;
            if (lane == 0) sxw[sl] = amax > 0.f ? amax * (1.0f / 127.0f) : 1.0f;
        }
        {
            const unsigned char* xw = xwp;
            int entA = (int)lst[lane];
            float suA, gsA;
            { const int e = entA >> 17, slot = (entA >> 14) & 7, k = (entA >> 7) & 127; const size_t tk = (size_t)(tw + slot);
              suA = su[e] * sxw[slot]; gsA = gate[tk * 128 + k] * ginv[tk * 8 + (k >> 4)] * sv[e]; }
            u32x4 ub0[8], ub1[8], ub2[8], ub3[8];
            g2u_issue(u8, entA, 0, lane, ub0); g2u_issue(u8, entA, 8, lane, ub1); g2u_issue(u8, entA, 16, lane, ub2);
#pragma unroll 1
            for (int chunk = 0; chunk < 16; ++chunk) {
                const bool more = chunk < 15;
                const int entN = (int)lst[(more ? chunk + 1 : chunk) * 64 + lane];
                float suN, gsN;
                { const int e = entN >> 17, slot = (entN >> 14) & 7, k = (entN >> 7) & 127; const size_t tk = (size_t)(tw + slot);
                  suN = su[e] * sxw[slot]; gsN = gate[tk * 128 + k] * ginv[tk * 8 + (k >> 4)] * sv[e]; }
                float actchunk = 0.f;
#define G2U_STEP(J, BC, BN) do { if (J + 3 < 8) g2u_issue(u8, entA, (J + 3) * 8, lane, BN); else if (more) g2u_issue(u8, entN, (J + 3 - 8) * 8, lane, BN); \
                    const float a_ = g2u_compute(xw, entA, suA, gsA, J * 8, lane, BC); const float v_ = __shfl(a_, (lane & 7) * 8); actchunk = ((lane >> 3) == J) ? v_ : actchunk; } while (0)
                G2U_STEP(0, ub0, ub3); G2U_STEP(1, ub1, ub0); G2U_STEP(2, ub2, ub1); G2U_STEP(3, ub3, ub2);
                G2U_STEP(4, ub0, ub3); G2U_STEP(5, ub1, ub0); G2U_STEP(6, ub2, ub1); G2U_STEP(7, ub3, ub2);
#undef G2U_STEP
                __hip_atomic_store(actw + ((entA >> 14) & 7) * 128 + (entA & 127), actchunk, __ATOMIC_RELAXED, __HIP_MEMORY_SCOPE_AGENT);
                entA = entN; suA = suN; gsA = gsN;
            }
        }
        asm volatile("s_waitcnt vmcnt(0)" ::: "memory");
        f32x2 acc[8][8];
        {
        const bf16_t* xrow = x1b + (size_t)(tw + (lane >> 3)) * 1024 + 16 * (lane & 7);
#pragma unroll
        for (int c = 0; c < 8; ++c) {
            const u32x4 a = *(const u32x4*)(xrow + c * 128), b = *(const u32x4*)(xrow + c * 128 + 8);
            acc[c][0] = (f32x2){DN_ALPHA * bf_lo(a.x), DN_ALPHA * bf_hi(a.x)}; acc[c][1] = (f32x2){DN_ALPHA * bf_lo(a.y), DN_ALPHA * bf_hi(a.y)};
            acc[c][2] = (f32x2){DN_ALPHA * bf_lo(a.z), DN_ALPHA * bf_hi(a.z)}; acc[c][3] = (f32x2){DN_ALPHA * bf_lo(a.w), DN_ALPHA * bf_hi(a.w)};
            acc[c][4] = (f32x2){DN_ALPHA * bf_lo(b.x), DN_ALPHA * bf_hi(b.x)}; acc[c][5] = (f32x2){DN_ALPHA * bf_lo(b.y), DN_ALPHA * bf_hi(b.y)};
            acc[c][6] = (f32x2){DN_ALPHA * bf_lo(b.z), DN_ALPHA * bf_hi(b.z)}; acc[c][7] = (f32x2){DN_ALPHA * bf_lo(b.w), DN_ALPHA * bf_hi(b.w)};
        }
        {
            const int grp = lane & ~7, li = lane & 7;
            const unsigned char* vlane = v8 + li * 16;
            const float* aw = actw + (lane >> 3) * 128 + li; const unsigned* ew = expw + (lane >> 3) * 128 + li;
            int ecur = (int)__hip_atomic_load(ew, __ATOMIC_RELAXED, __HIP_MEMORY_SCOPE_AGENT);
            float acur = __hip_atomic_load(aw, __ATOMIC_RELAXED, __HIP_MEMORY_SCOPE_AGENT);
            u32x4 vbA[8], vbB[8];
            g2v_issue(vlane, __shfl(ecur, grp), vbA);
#pragma unroll 1
            for (int k0 = 0; k0 < 128; k0 += 8) {
                __syncthreads();
                const int kn = (k0 + 8 < 128) ? k0 + 8 : k0;
                const int enext = (int)__hip_atomic_load(ew + kn, __ATOMIC_RELAXED, __HIP_MEMORY_SCOPE_AGENT);
                const float anext = __hip_atomic_load(aw + kn, __ATOMIC_RELAXED, __HIP_MEMORY_SCOPE_AGENT);
#define G2V_STEP(KK, VC, VN) do { const int en_ = (KK < 7) ? __shfl(ecur, grp | (KK + 1)) : __shfl(enext, grp); \
                    if (KK < 7 || k0 + 8 < 128) g2v_issue(vlane, en_, VN); g2v_compute(acc, __shfl(acur, grp | KK), VC); } while (0)
                G2V_STEP(0, vbA, vbB); G2V_STEP(1, vbB, vbA); G2V_STEP(2, vbA, vbB); G2V_STEP(3, vbB, vbA);
                G2V_STEP(4, vbA, vbB); G2V_STEP(5, vbB, vbA); G2V_STEP(6, vbA, vbB); G2V_STEP(7, vbB, vbA);
#undef G2V_STEP
                ecur = enext; acur = anext;
            }
        }
        }
        {
            float sm = 0.f;
#pragma unroll
            for (int c = 0; c < 8; ++c)
#pragma unroll
                for (int j = 0; j < 8; ++j) sm += acc[c][j].x + acc[c][j].y;
            sm += dpp_f<0xB1>(sm); sm += dpp_f<0x4E>(sm); sm += dpp_f<0x141>(sm);
            const float mean = sm * (1.0f / 1024.0f);
            const f32x2 nm2 = {-mean, -mean}; f32x2 q2 = {0.f, 0.f};
#pragma unroll
            for (int c = 0; c < 8; ++c)
#pragma unroll
                for (int j = 0; j < 8; ++j) { asm("v_pk_add_f32 %0, %0, %1" : "+v"(acc[c][j]) : "v"(nm2)); q2 = __builtin_elementwise_fma(acc[c][j], acc[c][j], q2); }
            float q = q2.x + q2.y;
            q += dpp_f<0xB1>(q); q += dpp_f<0x4E>(q); q += dpp_f<0x141>(q);
            const float rstd = rsqrtf(q * (1.0f / 1024.0f) + LN_EPS);
            int l2 = lane; asm volatile("" : "+v"(l2));
            const float* gp = p.ln2_g + 16 * (l2 & 7); const float* bp = p.ln2_b + 16 * (l2 & 7);
            float* orow = p.out + (size_t)(tw + (l2 >> 3)) * 1024 + 16 * (l2 & 7);
#pragma unroll
            for (int c = 0; c < 8; ++c)
#pragma unroll
                for (int i = 0; i < 4; ++i) {
                    const f32x4 gg = *(const f32x4*)(gp + c * 128 + 4 * i), bb = *(const f32x4*)(bp + c * 128 + 4 * i);
                    f32x4 o;
                    o[0] = acc[c][2 * i].x * rstd * gg[0] + bb[0]; o[1] = acc[c][2 * i].y * rstd * gg[1] + bb[1];
                    o[2] = acc[c][2 * i + 1].x * rstd * gg[2] + bb[2]; o[3] = acc[c][2 * i + 1].y * rstd * gg[3] + bb[3];
                    *(f32x4*)(orow + c * 128 + 4 * i) = o;
                    if (i == 3) __builtin_amdgcn_sched_barrier(0);
                }
        }
    }
}

#define XB_TMO      128
#define XB_XCNT(j)  (256  + 64 * (j))
#define XB_XSUB(j)  (1280 + 64 * (j))
#define XB_XGEN(j)  (2304 + 64 * (j))
#define XB_TOP      3328
#define XB_TOPGEN   3392
#define XCD_BAR_WORDS 3456
#define XB_SPIN_CAP (1u << 18)
#define LAS __attribute__((address_space(3)))
__device__ __forceinline__ unsigned xb_ld(unsigned* p)              { return __hip_atomic_load(p, __ATOMIC_RELAXED, __HIP_MEMORY_SCOPE_AGENT); }
__device__ __forceinline__ unsigned xb_add(unsigned* p, unsigned v) { return __hip_atomic_fetch_add(p, v, __ATOMIC_RELAXED, __HIP_MEMORY_SCOPE_AGENT); }
__device__ __forceinline__ unsigned xb_xcc_id() { return (unsigned)__builtin_amdgcn_s_getreg((3 << 11) | 20) & 0xFu; }
#define XB_SPIN(cond, bar) do { unsigned _sp = 0; while (cond) { __builtin_amdgcn_s_sleep(1); \
    if ((++_sp & 255u) == 0u) { if (xb_ld(&(bar)[XB_TMO])) break; if (_sp > XB_SPIN_CAP) { atomicAdd(&(bar)[XB_TMO], 1u); break; } } } } while (0)
struct XcdBarrier { unsigned* bar; unsigned x; volatile LAS unsigned* st; };
__device__ __forceinline__ XcdBarrier xcd_barrier_post(unsigned* bar, volatile LAS unsigned* st) {
    XcdBarrier b; b.bar = bar; b.x = xb_xcc_id(); b.st = st;
    if (threadIdx.x == 0) (void)xb_add(&bar[XB_XCNT(b.x)], 1u);
    return b;
}
__device__ __forceinline__ void xcd_barrier_complete(unsigned* bar, unsigned x, unsigned& nloc, unsigned& nx) {
    const unsigned G = gridDim.x * gridDim.y * gridDim.z;
    unsigned sum, cnt, mine, sp = 0u;
    for (;;) {
        sum = 0u; cnt = 0u; mine = 0u;
#pragma unroll
        for (unsigned j = 0; j < 16; ++j) { const unsigned c = xb_ld(&bar[XB_XCNT(j)]); sum += c; cnt += (c > 0u) ? 1u : 0u; mine = (j == x) ? c : mine; }
        if (sum == G) break;
        __builtin_amdgcn_s_sleep(1);
        if ((++sp & 255u) == 0u) { if (xb_ld(&bar[XB_TMO])) break; if (sp > XB_SPIN_CAP) { atomicAdd(&bar[XB_TMO], 1u); break; } }
    }
    nloc = mine > 0u ? mine : 1u; nx = cnt > 0u ? cnt : 1u;
}
__device__ __forceinline__ void xcd_barrier(const XcdBarrier& b) {
    asm volatile("s_waitcnt vmcnt(0)" ::: "memory");
    __syncthreads();
    if (threadIdx.x == 0) {
        unsigned* bar = b.bar;
        __builtin_amdgcn_s_waitcnt(0);
        unsigned nloc = b.st[0], nx = b.st[1];
        if (nloc == 0u) { xcd_barrier_complete(bar, b.x, nloc, nx); b.st[0] = nloc; b.st[1] = nx; }
        const unsigned old = xb_add(&bar[XB_XSUB(b.x)], 1u);
        const unsigned gen = old / nloc;
        if (old + 1u == (gen + 1u) * nloc) {
            __builtin_amdgcn_fence(__ATOMIC_RELEASE, "agent");
            asm volatile("s_waitcnt vmcnt(0)" ::: "memory");
            const unsigned og = xb_add(&bar[XB_TOP], 1u);
            const unsigned tg = og / nx;
            if (og + 1u == (tg + 1u) * nx) xb_add(&bar[XB_TOPGEN], 1u);
            else XB_SPIN(xb_ld(&bar[XB_TOPGEN]) == tg, bar);
            __builtin_amdgcn_fence(__ATOMIC_ACQUIRE, "agent");
            xb_add(&bar[XB_XGEN(b.x)], 1u);
            asm volatile("s_waitcnt vmcnt(0)" ::: "memory");
        } else {
            XB_SPIN(xb_ld(&bar[XB_XGEN(b.x)]) == gen, bar);
            __builtin_amdgcn_fence(__ATOMIC_ACQUIRE, "agent");
            asm volatile("s_waitcnt vmcnt(0)" ::: "memory");
        }
    }
    __syncthreads();
}

__device__ __forceinline__ void run_phase(int ph, const Params& p, unsigned char* smem, bool dummy = false, const XcdBarrier* rb = nullptr) {
    if (ph == 0) phase_prep(p, smem);
    if (ph == 1) { pg8::Gemm g{(const bf16_t*)(p.ws + WS_H0B), (const bf16_t*)(p.ws + WS_WIN), T_, 2048, 1024}; pg8::StaticOrder S; S.init(T_, 2048, gridDim.x, blockIdx.x);
        EpiG1 e{(bf16_t*)(p.ws + WS_HCAT), (bf16_t*)(p.ws + WS_VT)}; pg8::gemm_phase((PG8_LAS unsigned char*)smem, g, S, e); }
    if (ph == 2) {
        phase_attn(p, smem); phase_poolprep(p);
        asm volatile("s_waitcnt vmcnt(0)" ::: "memory"); __syncthreads();
        EpiPool e{(bf16_t*)(p.ws + WS_MIX), p.pool_b, p.pool_scale};
        gemm_phase((const bf16_t*)(p.ws + WS_POOLED), 512, 256, (const bf16_t*)(p.ws + WS_POOLW), 256, 65536, T_, 256, 256, 2, e, smem);
    }
    if (ph == 4) { pg8::Gemm g{(const bf16_t*)(p.ws + WS_MIX), (const bf16_t*)(p.ws + WS_WOUT), T_, 1024, 1024}; pg8::StaticOrder S; S.init(T_, 1024, gridDim.x, blockIdx.x);
        EpiG2 e{(const bf16_t*)(p.ws + WS_H0B), (bf16_t*)(p.ws + WS_HCAT)}; pg8::gemm_phase((PG8_LAS unsigned char*)smem, g, S, e); }
    if (ph == 5) phase_ln1(p);
    if (ph == 6) { pg8::Gemm g{(const bf16_t*)(p.ws + WS_H0B), (const bf16_t*)(p.ws + WS_WQ), T_, 2048, 1024}; pg8::StaticOrder S; S.init(T_, 2048, gridDim.x, blockIdx.x);
        EpiG3 e{(bf16_t*)(p.ws + WS_HCAT), 2048}; pg8::gemm_phase((PG8_LAS unsigned char*)smem, g, S, e); }
    if (ph == 7) phase_topk(p, smem);
    if (ph == 8) phase_gather2(p, smem);
}

constexpr int PROBE_PH = -1;
constexpr int LDS_BYTES = G2_LDS_BYTES;
__global__ void __launch_bounds__(NTHREADS, 2) k_mega(Params p) {
    extern __shared__ __attribute__((aligned(16))) unsigned char smem[];
    volatile LAS unsigned* st = (volatile LAS unsigned*)(smem + LDS_BYTES - 16);
    if (threadIdx.x < 4) st[threadIdx.x] = 0u;
    __syncthreads();
    const XcdBarrier bar = xcd_barrier_post((unsigned*)(p.ws + WS_CTL), st);
    if (PROBE_PH == 0) run_phase(0, p, smem, true);
    run_phase(0, p, smem); xcd_barrier(bar);
    if (PROBE_PH == 1) run_phase(1, p, smem, true);
    run_phase(1, p, smem); xcd_barrier(bar);
    if (PROBE_PH == 2) run_phase(2, p, smem, true);
    run_phase(2, p, smem); xcd_barrier(bar);
    if (PROBE_PH == 4) run_phase(4, p, smem, true);
    run_phase(4, p, smem); xcd_barrier(bar);
    if (PROBE_PH == 5) run_phase(5, p, smem, true);
    run_phase(5, p, smem); xcd_barrier(bar);
    if (PROBE_PH == 6) run_phase(6, p, smem, true);
    run_phase(6, p, smem); xcd_barrier(bar);
    if (PROBE_PH == 7) run_phase(7, p, smem, true);
    run_phase(7, p, smem); xcd_barrier(bar);
    if (PROBE_PH == 8) run_phase(8, p, smem, true);
    run_phase(8, p, smem, false, nullptr);
}

extern "C" void kernel_launch(void* const* d_in, const int* in_sizes, int n_in, void* d_out, int out_size, void* d_ws, size_t ws_size, hipStream_t stream) {
    if (n_in != 16 || out_size != T_ * D_ || ws_size < WS_END) {
        fprintf(stderr, "kernel_launch: unexpected problem (n_in %d, out %d, ws %zu < %zu)\n", n_in, out_size, ws_size, (size_t)WS_END);
        return;
    }
    static int grid_blocks = 0;
    if (!grid_blocks) {
        int dev = 0, cus = 0, per_cu = 0;
        hipGetDevice(&dev);
        hipDeviceGetAttribute(&cus, hipDeviceAttributeMultiprocessorCount, dev);
        if (hipFuncSetAttribute((const void*)k_mega, hipFuncAttributeMaxDynamicSharedMemorySize, LDS_BYTES) != hipSuccess) { fprintf(stderr, "kernel_launch: hipFuncSetAttribute failed\n"); grid_blocks = -1; return; }
        (void)hipOccupancyMaxActiveBlocksPerMultiprocessor(&per_cu, (const void*)k_mega, NTHREADS, LDS_BYTES);
        if (per_cu < 1) { fprintf(stderr, "kernel_launch: occupancy query says %d blocks per CU\n", per_cu); grid_blocks = -1; }
        else grid_blocks = cus;
    }
    if (grid_blocks < 0) return;
    Params p{};
    p.x = (const float*)d_in[0]; p.ln0_g = (const float*)d_in[1]; p.ln0_b = (const float*)d_in[2]; p.w_in = (const float*)d_in[3];
    p.pool_w = (const float*)d_in[4]; p.pool_b = (const float*)d_in[5]; p.pool_scale = (const float*)d_in[6]; p.w_out = (const float*)d_in[7];
    p.ln1_g = (const float*)d_in[8]; p.ln1_b = (const float*)d_in[9]; p.wq = (const float*)d_in[10]; p.subk = (const float*)d_in[11];
    p.pu = (const float*)d_in[12]; p.pv = (const float*)d_in[13]; p.ln2_g = (const float*)d_in[14]; p.ln2_b = (const float*)d_in[15];
    p.out = (float*)d_out; p.ws = (unsigned char*)d_ws;
    (void)hipMemsetAsync((unsigned char*)d_ws + WS_CTL, 0, 16384, stream);
    void* args[] = {&p};
    hipError_t e = hipLaunchCooperativeKernel((const void*)k_mega, dim3(grid_blocks), dim3(NTHREADS), args, LDS_BYTES, stream);
    if (e != hipSuccess) fprintf(stderr, "kernel_launch: cooperative launch failed: %s (grid %d)\n", hipGetErrorString(e), grid_blocks);
}
```

```cpp
#include <hip/hip_runtime.h>
#include <hip/hip_cooperative_groups.h>
#include <cstdio>
#include <cstdint>

namespace cg = cooperative_groups;

typedef unsigned short bf16_t;
typedef short bf16x8 __attribute__((ext_vector_type(8)));
typedef float f32x4 __attribute__((ext_vector_type(4)));
typedef float f32x16 __attribute__((ext_vector_type(16)));
typedef unsigned u32x4 __attribute__((ext_vector_type(4)));
typedef unsigned u32x2 __attribute__((ext_vector_type(2)));

constexpr int T_ = 16384, D_ = 1024, S_ = 2048;
constexpr int NTHREADS = 512, NWAVES = 8;
constexpr float LN_EPS = 1e-5f;
constexpr float DN_ALPHA = 1.189207115002721f;

constexpr size_t MB = 1024 * 1024;
constexpr size_t WS_CTL = 0;
constexpr size_t WS_H0B = 64 * 1024;
constexpr size_t WS_WIN = WS_H0B + 32 * MB;
constexpr size_t WS_WOUT = WS_WIN + 4 * MB;
constexpr size_t WS_WQ = WS_WOUT + 2 * MB;
constexpr size_t WS_POOLW = WS_WQ + 4 * MB;
constexpr size_t WS_SUBK = WS_POOLW + 256 * 1024;
constexpr size_t WS_UB = WS_SUBK + 64 * 1024;
constexpr size_t WS_U8 = WS_UB, WS_V8 = WS_UB + 16 * MB;
constexpr size_t WS_VB = WS_UB + 32 * MB;
constexpr size_t WS_SU = WS_VB, WS_SV = WS_VB + 64 * 1024;
constexpr size_t WS_HCAT = WS_VB + 32 * MB;
constexpr size_t WS_VT = WS_HCAT + 48 * MB;
constexpr size_t WS_MIX = WS_VT + 16 * MB;
constexpr size_t WS_POOLED = WS_MIX + 32 * MB;
constexpr size_t WS_END = WS_POOLED + 16 * MB;

struct Params {
    const float *x, *ln0_g, *ln0_b, *w_in, *pool_w, *pool_b, *pool_scale, *w_out, *ln1_g, *ln1_b, *wq, *subk, *pu, *pv, *ln2_g, *ln2_b;
    float* out;
    unsigned char* ws;
};

typedef float f32x2 __attribute__((ext_vector_type(2)));
typedef __bf16 bf16x2n __attribute__((ext_vector_type(2)));
__device__ __forceinline__ unsigned pk_bf16(float lo, float hi) { const f32x2 v = {lo, hi}; return __builtin_bit_cast(unsigned, __builtin_convertvector(v, bf16x2n)); }
__device__ __forceinline__ bf16_t f2bf(float f) { return (bf16_t)(pk_bf16(f, 0.f) & 0xffffu); }
__device__ __forceinline__ float bf_lo(unsigned u) { return __uint_as_float(u << 16); }
__device__ __forceinline__ float bf_hi(unsigned u) { return __uint_as_float(u & 0xffff0000u); }
template <int CTRL> __device__ __forceinline__ float dpp_f(float x) { return __int_as_float(__builtin_amdgcn_update_dpp(0, __float_as_int(x), CTRL, 0xF, 0xF, true)); }
__device__ __forceinline__ float row_sum16(float x) { x += dpp_f<0x128>(x); x += dpp_f<0x124>(x); x += dpp_f<0x122>(x); x += dpp_f<0x121>(x); return x; }
__device__ __forceinline__ float swap16_add(float a, float b) { const auto q = __builtin_amdgcn_permlane16_swap(__float_as_uint(a), __float_as_uint(b), false, false); return __uint_as_float(q[0]) + __uint_as_float(q[1]); }
__device__ __forceinline__ float swap32_add(float a, float b) { const auto q = __builtin_amdgcn_permlane32_swap(__float_as_uint(a), __float_as_uint(b), false, false); return __uint_as_float(q[0]) + __uint_as_float(q[1]); }
__device__ __forceinline__ float wave_sum(float v) { v = row_sum16(v); v = swap16_add(v, v); return swap32_add(v, v); }

__device__ __forceinline__ void ln_row(const float* src, const float* g, const float* b, float* dst32, bf16_t* dst16, int lane) {
    f32x4 v[4];
    float s = 0.f;
#pragma unroll
    for (int i = 0; i < 4; ++i) { v[i] = *(const f32x4*)(src + lane * 4 + i * 256); s += (v[i][0] + v[i][1]) + (v[i][2] + v[i][3]); }
    const float mean = wave_sum(s) * (1.0f / 1024.0f);
    float q = 0.f;
#pragma unroll
    for (int i = 0; i < 4; ++i) { f32x4 d = v[i] - mean; q += (d[0] * d[0] + d[1] * d[1]) + (d[2] * d[2] + d[3] * d[3]); }
    const float rstd = rsqrtf(wave_sum(q) * (1.0f / 1024.0f) + LN_EPS);
#pragma unroll
    for (int i = 0; i < 4; ++i) {
        const f32x4 gg = *(const f32x4*)(g + lane * 4 + i * 256), bb = *(const f32x4*)(b + lane * 4 + i * 256);
        const f32x4 y = (v[i] - mean) * rstd * gg + bb;
        if (dst32) *(f32x4*)(dst32 + lane * 4 + i * 256) = y;
        if (dst16) { u32x2 o; o.x = pk_bf16(y[0], y[1]); o.y = pk_bf16(y[2], y[3]); *(u32x2*)(dst16 + lane * 4 + i * 256) = o; }
    }
}

__device__ __forceinline__ void ln_rows4(const float* src, size_t rstride, const float* g, const float* b, bf16_t* dst16, int lane) {
    f32x4 v[4][4];
#pragma unroll
    for (int j = 0; j < 4; ++j)
#pragma unroll
        for (int i = 0; i < 4; ++i) v[j][i] = *(const f32x4*)(src + j * rstride + lane * 4 + i * 256);
    f32x4 gg[4], bb[4];
#pragma unroll
    for (int i = 0; i < 4; ++i) { gg[i] = *(const f32x4*)(g + lane * 4 + i * 256); bb[i] = *(const f32x4*)(b + lane * 4 + i * 256); }
#pragma unroll
    for (int j = 0; j < 4; ++j) {
        float s = 0.f;
#pragma unroll
        for (int i = 0; i < 4; ++i) s += (v[j][i][0] + v[j][i][1]) + (v[j][i][2] + v[j][i][3]);
        const float mean = wave_sum(s) * (1.0f / 1024.0f);
        float q = 0.f;
#pragma unroll
        for (int i = 0; i < 4; ++i) { const f32x4 d = v[j][i] - mean; q += (d[0] * d[0] + d[1] * d[1]) + (d[2] * d[2] + d[3] * d[3]); }
        const float rstd = rsqrtf(wave_sum(q) * (1.0f / 1024.0f) + LN_EPS);
#pragma unroll
        for (int i = 0; i < 4; ++i) {
            const f32x4 y = (v[j][i] - mean) * rstd * gg[i] + bb[i];
            u32x2 o; o.x = pk_bf16(y[0], y[1]); o.y = pk_bf16(y[2], y[3]); *(u32x2*)(dst16 + j * rstride + lane * 4 + i * 256) = o;
        }
    }
}

__device__ __forceinline__ void transpose_tile_wave(const float* W, int N, int k0, int n0, bf16_t* Wt, int ldt, int nout0, int kout0, float* tile  , int lane) {
    float v[64];
#pragma unroll
    for (int k = 0; k < 64; ++k) v[k] = W[(size_t)(k0 + k) * N + n0 + lane];
#pragma unroll
    for (int k = 0; k < 64; ++k) tile[k * 65 + lane] = v[k];
    asm volatile("s_waitcnt lgkmcnt(0)" ::: "memory");
#pragma unroll
    for (int n = 0; n < 64; ++n) Wt[(size_t)(nout0 + n) * ldt + kout0 + lane] = f2bf(tile[lane * 65 + n]);
    asm volatile("s_waitcnt lgkmcnt(0)" ::: "memory");
}

__device__ __forceinline__ unsigned q8x4(float a, float b, float c, float d) {
    unsigned w = 0;
    w = __builtin_amdgcn_cvt_pk_u8_f32(__builtin_rintf(a) + 128.f, 0, w); w = __builtin_amdgcn_cvt_pk_u8_f32(__builtin_rintf(b) + 128.f, 1, w);
    w = __builtin_amdgcn_cvt_pk_u8_f32(__builtin_rintf(c) + 128.f, 2, w); w = __builtin_amdgcn_cvt_pk_u8_f32(__builtin_rintf(d) + 128.f, 3, w);
    return w ^ 0x80808080u;
}
__device__ __forceinline__ void convert_table_rows4(const Params& p, int r0, int lane) {
    const int tbl = r0 >> 14, row0 = r0 & 16383;
    const float* src = (tbl ? p.pv : p.pu) + (size_t)row0 * 1024 + 16 * lane;
    f32x4 v[4][4];
#pragma unroll
    for (int j = 0; j < 4; ++j)
#pragma unroll
        for (int i = 0; i < 4; ++i) v[j][i] = *(const f32x4*)(src + (size_t)j * 1024 + 4 * i);
#pragma unroll
    for (int j = 0; j < 4; ++j) {
        float amax = 0.f;
#pragma unroll
        for (int i = 0; i < 4; ++i) amax = fmaxf(amax, fmaxf(fmaxf(fabsf(v[j][i][0]), fabsf(v[j][i][1])), fmaxf(fabsf(v[j][i][2]), fabsf(v[j][i][3]))));
#pragma unroll
        for (int o = 32; o > 0; o >>= 1) amax = fmaxf(amax, __shfl_xor(amax, o));
        const float top = tbl ? 416.0f : 127.0f;
        const float sc = amax > 0.f ? top / amax : 1.0f, inv = amax > 0.f ? amax / top : 1.0f;
        u32x4 w;
        if (tbl) {
#pragma unroll
            for (int i = 0; i < 4; ++i) { int t = __builtin_amdgcn_cvt_pk_fp8_f32(v[j][i][0] * sc, v[j][i][1] * sc, 0, false); t = __builtin_amdgcn_cvt_pk_fp8_f32(v[j][i][2] * sc, v[j][i][3] * sc, t, true); w[i] = (unsigned)t; }
        } else {
#pragma unroll
            for (int i = 0; i < 4; ++i) w[i] = q8x4(v[j][i][0] * sc, v[j][i][1] * sc, v[j][i][2] * sc, v[j][i][3] * sc);
        }
        *(u32x4*)(p.ws + (tbl ? WS_V8 : WS_U8) + (size_t)(row0 + j) * 1024 + 16 * lane) = w;
        if (lane == 0) ((float*)(p.ws + (tbl ? WS_SV : WS_SU)))[row0 + j] = inv;
    }
}

__device__ void phase_prep(const Params& p, unsigned char* smem) {
    const int tid = threadIdx.x, lane = tid & 63, wid = tid >> 6;
    const int gw = blockIdx.x * NWAVES + wid, nw = gridDim.x * NWAVES;
    const size_t gtid = (size_t)blockIdx.x * NTHREADS + tid, nthr = (size_t)gridDim.x * NTHREADS;
    bf16_t* h0b = (bf16_t*)(p.ws + WS_H0B);
    for (int r = gw; r + 3 * nw < T_; r += 4 * nw) ln_rows4(p.x + (size_t)r * D_, (size_t)nw * D_, p.ln0_g, p.ln0_b, h0b + (size_t)r * D_, lane);
    if (T_ % (4 * nw) != 0) for (int r = gw + (T_ / (4 * nw)) * 4 * nw; r < T_; r += nw) ln_row(p.x + (size_t)r * D_, p.ln0_g, p.ln0_b, nullptr, h0b + (size_t)r * D_, lane);
    {
        u32x2* sk = (u32x2*)(p.ws + WS_SUBK);
        for (size_t i = gtid; i < 2 * 128 * 128 / 4; i += nthr) { const f32x4 a = ((const f32x4*)p.subk)[i]; u32x2 o; o.x = pk_bf16(a[0], a[1]); o.y = pk_bf16(a[2], a[3]); sk[i] = o; }
        bf16_t* pw = (bf16_t*)(p.ws + WS_POOLW);
        for (size_t i = gtid; i < 2 * 2 * 128 * 128; i += nthr) {
            const int half = (int)(i >> 15), blk = (int)((i >> 14) & 1), r = (int)((i >> 7) & 127), c = (int)(i & 127);
            pw[(size_t)half * 65536 + (size_t)(blk * 128 + r) * 256 + ((1 - blk) * 128 + c)] = 0;
        }
    }
    float* tile = (float*)smem + wid * (64 * 65);
    constexpr int T_IN = 16 * 32, T_OUT = 16 * 16, T_Q = 16 * 32, T_POOL = 16;
    for (int it = gw; it < T_IN + T_OUT + T_Q + T_POOL; it += nw) {
        if (it < T_IN) { const int kt = it >> 5, nt = it & 31; transpose_tile_wave(p.w_in, 2048, kt * 64, nt * 64, (bf16_t*)(p.ws + WS_WIN), 1024, nt * 64, kt * 64, tile, lane); }
        else if (it < T_IN + T_OUT) { const int j = it - T_IN, kt = j >> 4, nt = j & 15; transpose_tile_wave(p.w_out, 1024, kt * 64, nt * 64, (bf16_t*)(p.ws + WS_WOUT), 1024, nt * 64, kt * 64, tile, lane); }
        else if (it < T_IN + T_OUT + T_Q) { const int j = it - T_IN - T_OUT, kt = j >> 5, nt = j & 31; transpose_tile_wave(p.wq, 2048, kt * 64, nt * 64, (bf16_t*)(p.ws + WS_WQ), 1024, nt * 64, kt * 64, tile, lane); }
        else { const int j = it - T_IN - T_OUT - T_Q, g = j >> 2, kt = (j >> 1) & 1, nt = j & 1, half = g >> 1, gg = g & 1;
            transpose_tile_wave(p.pool_w + (size_t)g * 128 * 128, 128, kt * 64, nt * 64, (bf16_t*)(p.ws + WS_POOLW) + (size_t)half * 65536, 256, gg * 128 + nt * 64, gg * 128 + kt * 64, tile, lane); }
    }
}

constexpr int BM = 128, BN = 256, BK = 64, LDT = 72;
constexpr int GEMM_LDS_BYTES = (BM + BN) * LDT * 2;

template <class Epi>
__device__ void gemm_phase(const bf16_t* A, int lda, long strideA, const bf16_t* Bt, int ldb, long strideB, int M, int N, int K, int nbatch, const Epi& epi, unsigned char* smem) {
    bf16_t* As = (bf16_t*)smem; bf16_t* Bs = As + BM * LDT;
    const int tid = threadIdx.x, lane = tid & 63, wid = tid >> 6, wr = wid >> 2, wc = wid & 3, fr = lane & 15, fq = lane >> 4;
    const int ntm = M / BM, ntn = N / BN, tiles_per = ntm * ntn, total = tiles_per * nbatch, nk = K / BK;
    const int lrow = tid >> 3, lch = tid & 7;
    for (int tile = blockIdx.x; tile < total; tile += gridDim.x) {
        const int bz = tile / tiles_per, tt = tile - bz * tiles_per, tm = tt / ntn, tn = tt - tm * ntn;
        const bf16_t* Ab = A + (size_t)bz * strideA + (size_t)(tm * BM + lrow) * lda + lch * 8;
        const bf16_t* Bb = Bt + (size_t)bz * strideB + (size_t)(tn * BN + lrow) * ldb + lch * 8;
        u32x4 ra[2], rb[4];
#pragma unroll
        for (int i = 0; i < 2; ++i) ra[i] = *(const u32x4*)(Ab + (size_t)(64 * i) * lda);
#pragma unroll
        for (int i = 0; i < 4; ++i) rb[i] = *(const u32x4*)(Bb + (size_t)(64 * i) * ldb);
        f32x4 acc[4][4];
#pragma unroll
        for (int m = 0; m < 4; ++m)
#pragma unroll
            for (int n = 0; n < 4; ++n) acc[m][n] = (f32x4){0.f, 0.f, 0.f, 0.f};
        for (int kt = 0; kt < nk; ++kt) {
            __syncthreads();
#pragma unroll
            for (int i = 0; i < 2; ++i) *(u32x4*)(As + (lrow + 64 * i) * LDT + lch * 8) = ra[i];
#pragma unroll
            for (int i = 0; i < 4; ++i) *(u32x4*)(Bs + (lrow + 64 * i) * LDT + lch * 8) = rb[i];
            __syncthreads();
            if (kt + 1 < nk) {
#pragma unroll
                for (int i = 0; i < 2; ++i) ra[i] = *(const u32x4*)(Ab + (size_t)(64 * i) * lda + (kt + 1) * BK);
#pragma unroll
                for (int i = 0; i < 4; ++i) rb[i] = *(const u32x4*)(Bb + (size_t)(64 * i) * ldb + (kt + 1) * BK);
            }
#pragma unroll
            for (int ks = 0; ks < 2; ++ks) {
                bf16x8 af[4], bfr[4];
#pragma unroll
                for (int m = 0; m < 4; ++m) af[m] = *(const bf16x8*)(As + (wr * 64 + m * 16 + fr) * LDT + ks * 32 + fq * 8);
#pragma unroll
                for (int n = 0; n < 4; ++n) bfr[n] = *(const bf16x8*)(Bs + (wc * 64 + n * 16 + fr) * LDT + ks * 32 + fq * 8);
#pragma unroll
                for (int m = 0; m < 4; ++m)
#pragma unroll
                    for (int n = 0; n < 4; ++n) acc[m][n] = __builtin_amdgcn_mfma_f32_16x16x32_bf16(bfr[n], af[m], acc[m][n], 0, 0, 0);
            }
        }
#pragma unroll
        for (int m = 0; m < 4; ++m)
#pragma unroll
            for (int n = 0; n < 4; ++n) epi(bz, tm * BM + wr * 64 + m * 16 + fr, tn * BN + wc * 64 + n * 16 + fq * 4, acc[m][n]);
    }
}

struct EpiPool {
    bf16_t* mix; const float* pb; const float* ps;
    __device__ __forceinline__ void operator()(int bz, int row, int col, f32x4 v) const {
        const int gc = bz * 256 + col;
        const f32x4 b = *(const f32x4*)(pb + gc), s = *(const f32x4*)(ps + gc);
        const f32x4 y = (v + b) * s;
        u32x2 o; o.x = pk_bf16(y[0], y[1]); o.y = pk_bf16(y[2], y[3]); *(u32x2*)(mix + (size_t)row * 1024 + gc) = o;
    }
};
namespace pg8 {
#define PG8_LAS __attribute__((address_space(3)))
constexpr int BM = 256, BK = 64, HALF = 128, HTB = HALF * BK * 2  , STAGE_BYTES = 8 * HTB, NXCD = 8, WGM = 8;
__host__ __device__ __forceinline__ int lds_byte(int r, int c) { const int st = (r >> 4) * 2 + (c >> 5), rr = r & 15, cc = c & 31, ob = rr * 64 + cc * 2; return st * 1024 + (ob ^ (((ob >> 9) & 1) << 5)); }
__host__ __device__ __forceinline__ void stage_rc(int b, int& R, int& C) { const int st = b / 1024, sb = b % 1024, swz = sb ^ (((sb >> 9) & 1) << 5); R = (st >> 1) * 16 + swz / 64; C = (st & 1) * 32 + (swz % 64) / 2; }
__host__ __device__ __forceinline__ int perm32(int rho) { const int n = rho >> 4, i = rho & 15; return 8 * (i >> 2) + 4 * n + (i & 3); }
struct Unit { int pm, pn; };
struct Gemm { const bf16_t* A; const bf16_t* Bt; int M, N, K; };
struct StaticOrder {
    int nM, nN, nwg, G, c;
    __host__ __device__ void init(int M, int N, int G_, int c_) { nM = M / BM; nN = N / BM; nwg = nM * nN; G = G_; c = c_; }
    __host__ __device__ bool next(int i, Unit& u) const {
        const long L = (long)i * G + c; if (L >= nwg) return false;
        int wgid = (int)L; { const int q = nwg / NXCD, r = nwg % NXCD, xcd = wgid % NXCD, off = wgid / NXCD; wgid = (xcd < r ? xcd * (q + 1) : r * (q + 1) + (xcd - r) * q) + off; }
        const int nig = WGM * nN, gid = wgid / nig, fm = gid * WGM, gsz = (nM - fm) < WGM ? (nM - fm) : WGM;
        u.pm = fm + ((wgid % nig) % gsz); u.pn = (wgid % nig) / gsz; return true;
    }
    __device__ __forceinline__ void a_ready(const Unit&) const {}
    __device__ __forceinline__ void done(const Unit&) const {}
};
template <class Epi, class Sched>
__device__ __forceinline__ void gemm_phase(PG8_LAS unsigned char* lds, const Gemm g, const Sched& S, const Epi& E) {
    const int tid = threadIdx.x, wid = __builtin_amdgcn_readfirstlane(tid >> 6), lane = tid & 63, wr = wid >> 2, wc = wid & 3, fr = lane & 15, fq = lane >> 4;
    const int K = g.K, nt = K / BK;
    unsigned voffA[2], voffB[2];
#pragma unroll
    for (int i = 0; i < 2; ++i) { int R, C; stage_rc(tid * 16 + i * 8192, R, C); const int Rb = Epi::PERM ? ((R & ~31) + perm32(R & 31)) : R;
        voffA[i] = (unsigned)(R * K + C) * 2u; voffB[i] = (unsigned)(Rb * K + C) * 2u; }
    const size_t kstep = (size_t)(BK * 2);
    const size_t hstep = (size_t)HALF * K * 2;
    const size_t tstep = 2 * hstep;
    const unsigned ldsw = (unsigned)wid * 1024u;
    const int aoff = lds_byte(wr * 64 + fr, fq * 8), boff = lds_byte(wc * 32 + fr, fq * 8);
#define PG8_SA(b, h) (((b) * 2 + (h)) * HTB)
#define PG8_SB(b, h) ((4 + (b) * 2 + (h)) * HTB)
#define PG8_STAGE(bufoff, gbase, voff) do { _Pragma("unroll") for (int _i = 0; _i < 2; ++_i) \
        __builtin_amdgcn_global_load_lds((const unsigned*)((const char*)(gbase) + (voff)[_i]), (PG8_LAS unsigned*)(lds + (bufoff) + ldsw + _i * 8192), 16, 0, 0); } while (0)
#define PG8_LDA(dst, b, h) do { _Pragma("unroll") for (int m = 0; m < 4; ++m) _Pragma("unroll") for (int k = 0; k < 2; ++k) dst[m][k] = *(const PG8_LAS bf16x8*)(lds + PG8_SA(b, h) + aoff + m * 2048 + k * 1024); } while (0)
#define PG8_LDB(dst, b, h) do { _Pragma("unroll") for (int n = 0; n < 2; ++n) _Pragma("unroll") for (int k = 0; k < 2; ++k) dst[n][k] = *(const PG8_LAS bf16x8*)(lds + PG8_SB(b, h) + boff + n * 2048 + k * 1024); } while (0)
#define PG8_MMA(ai, bj, At, Bt) do { __builtin_amdgcn_s_setprio(1); _Pragma("unroll") for (int m = 0; m < 4; ++m) _Pragma("unroll") for (int n = 0; n < 2; ++n) _Pragma("unroll") for (int k = 0; k < 2; ++k) \
        acc[ai][bj][m][n] = __builtin_amdgcn_mfma_f32_16x16x32_bf16(Bt[n][k], At[m][k], acc[ai][bj][m][n], 0, 0, 0); __builtin_amdgcn_s_setprio(0); } while (0)
#define PG8_WAIT_V(n) asm volatile("s_waitcnt vmcnt(" #n ")" ::: "memory")
#define PG8_WAIT_L(n) asm volatile("s_waitcnt lgkmcnt(" #n ")" ::: "memory")
#define PG8_BAR __builtin_amdgcn_s_barrier()
#define PG8_SCHED __builtin_amdgcn_sched_barrier(0)
    Unit cur, nxt; int ui = 0;
    if (!S.next(0, cur)) return;
    f32x4 acc[2][2][4][2];
#pragma unroll
    for (int a = 0; a < 2; ++a)
#pragma unroll
        for (int b = 0; b < 2; ++b)
#pragma unroll
            for (int m = 0; m < 4; ++m)
#pragma unroll
                for (int n = 0; n < 2; ++n) acc[a][b][m][n] = (f32x4){0.f, 0.f, 0.f, 0.f};
    bf16x8 At[4][2], B0[2][2], B1[2][2];
    const char* cA = (const char*)g.A + (size_t)cur.pm * tstep; const char* cB = (const char*)g.Bt + (size_t)cur.pn * tstep;
    S.a_ready(cur);
    PG8_STAGE(PG8_SB(0, 0), cB, voffB); PG8_STAGE(PG8_SA(0, 0), cA, voffA); PG8_STAGE(PG8_SB(0, 1), cB + hstep, voffB); PG8_STAGE(PG8_SA(0, 1), cA + hstep, voffA);
    if (wr == 1) PG8_BAR;
    PG8_WAIT_V(4); PG8_BAR;
    PG8_STAGE(PG8_SB(1, 0), cB + kstep, voffB); PG8_STAGE(PG8_SA(1, 0), cA + kstep, voffA); PG8_STAGE(PG8_SB(1, 1), cB + hstep + kstep, voffB);
    PG8_WAIT_V(6); PG8_BAR;
    for (;;) {
        const bool has_next = S.next(ui + 1, nxt);
        const char* nA = has_next ? (const char*)g.A + (size_t)nxt.pm * tstep : cA; const char* nB = has_next ? (const char*)g.Bt + (size_t)nxt.pn * tstep : cB;
        for (int t = 0; t < nt; t += 2) {
            const bool last = (t == nt - 2);
            const char* a1 = cA + (size_t)(t + 1) * kstep;
            const char* a2 = last ? nA : cA + (size_t)(t + 2) * kstep; const char* b2 = last ? nB : cB + (size_t)(t + 2) * kstep;
            const char* a3 = a2 + kstep; const char* b3 = b2 + kstep;
            if (last && has_next) S.a_ready(nxt);
            PG8_LDB(B0, 0, 0); PG8_SCHED; PG8_LDA(At, 0, 0); PG8_STAGE(PG8_SA(1, 1), a1 + hstep, voffA);
            PG8_WAIT_L(8); PG8_BAR; PG8_WAIT_L(0); PG8_MMA(0, 0, At, B0); PG8_BAR; PG8_SCHED;
            PG8_LDB(B1, 0, 1); PG8_STAGE(PG8_SB(0, 0), b2, voffB);
            PG8_BAR; PG8_WAIT_L(0); PG8_MMA(0, 1, At, B1); PG8_BAR;
            PG8_LDA(At, 0, 1); PG8_STAGE(PG8_SA(0, 0), a2, voffA);
            PG8_BAR; PG8_WAIT_L(0); PG8_MMA(1, 0, At, B0); PG8_BAR; PG8_SCHED;
            PG8_STAGE(PG8_SB(0, 1), b2 + hstep, voffB);
            PG8_WAIT_V(6); PG8_BAR; PG8_MMA(1, 1, At, B1); PG8_BAR;
            PG8_LDB(B0, 1, 0); PG8_SCHED; PG8_LDA(At, 1, 0); PG8_STAGE(PG8_SA(0, 1), a2 + hstep, voffA);
            PG8_WAIT_L(8); PG8_BAR; PG8_WAIT_L(0); PG8_MMA(0, 0, At, B0); PG8_BAR; PG8_SCHED;
            PG8_LDB(B1, 1, 1); PG8_STAGE(PG8_SB(1, 0), b3, voffB);
            PG8_BAR; PG8_WAIT_L(0); PG8_MMA(0, 1, At, B1); PG8_BAR;
            PG8_LDA(At, 1, 1); PG8_STAGE(PG8_SA(1, 0), a3, voffA);
            PG8_BAR; PG8_WAIT_L(0); PG8_MMA(1, 0, At, B0); PG8_BAR; PG8_SCHED;
            PG8_STAGE(PG8_SB(1, 1), b3 + hstep, voffB);
            PG8_WAIT_V(6); PG8_BAR; PG8_MMA(1, 1, At, B1); PG8_BAR;
        }
        E(acc, cur, wr, wc, fr, fq); S.done(cur);
        if (!has_next) break;
#pragma unroll
        for (int a = 0; a < 2; ++a)
#pragma unroll
            for (int b = 0; b < 2; ++b)
#pragma unroll
                for (int m = 0; m < 4; ++m)
#pragma unroll
                    for (int n = 0; n < 2; ++n) acc[a][b][m][n] = (f32x4){0.f, 0.f, 0.f, 0.f};
        cur = nxt; cA = nA; cB = nB; ++ui;
    }
    PG8_WAIT_V(0);
    if (wr == 0) PG8_BAR;
    PG8_BAR;
#undef PG8_SA
#undef PG8_SB
#undef PG8_STAGE
#undef PG8_LDA
#undef PG8_LDB
#undef PG8_MMA
#undef PG8_WAIT_V
#undef PG8_WAIT_L
#undef PG8_BAR
#undef PG8_SCHED
}
}

struct EpiG1 {
    static constexpr bool PERM = true, AFTER_DRAIN = false;
    bf16_t* hcat; bf16_t* vT;
    __device__ __forceinline__ void operator()(const f32x4 (&acc)[2][2][4][2], const pg8::Unit& u, int wr, int wc, int fr, int fq) const {
        const int row0 = u.pm * 256 + wr * 64 + fr, col0 = u.pn * 256 + wc * 32 + 8 * fq;
#pragma unroll
        for (int ai = 0; ai < 2; ++ai)
#pragma unroll
            for (int m = 0; m < 4; ++m) {
                const int row = row0 + ai * 128 + m * 16;
#pragma unroll
                for (int bj = 0; bj < 2; ++bj) {
                    const int col = col0 + bj * 128; const f32x4 v0 = acc[ai][bj][m][0], v1 = acc[ai][bj][m][1];
                    if (u.pn < 6) { u32x4 w; w.x = pk_bf16(v0[0], v0[1]); w.y = pk_bf16(v0[2], v0[3]); w.z = pk_bf16(v1[0], v1[1]); w.w = pk_bf16(v1[2], v1[3]); *(u32x4*)(hcat + (size_t)row * 1536 + col) = w; }
                    else {
                        const int c = col - 1536, hh = c >> 6, d = c & 63, b = row >> 11, s = row & 2047;
                        bf16_t* dst = vT + ((size_t)((b * 8 + hh) * 64 + d)) * 2048 + s;
#pragma unroll
                        for (int j = 0; j < 4; ++j) { dst[(size_t)j * 2048] = f2bf(v0[j]); dst[(size_t)(4 + j) * 2048] = f2bf(v1[j]); }
                    }
                }
            }
    }
};
struct EpiG2 {
    static constexpr bool PERM = true, AFTER_DRAIN = false;
    const bf16_t* h0b; bf16_t* y1;
    __device__ __forceinline__ void operator()(const f32x4 (&acc)[2][2][4][2], const pg8::Unit& u, int wr, int wc, int fr, int fq) const {
        const int row0 = u.pm * 256 + wr * 64 + fr, col0 = u.pn * 256 + wc * 32 + 8 * fq;
#pragma unroll
        for (int ai = 0; ai < 2; ++ai)
#pragma unroll
            for (int m = 0; m < 4; ++m) {
                const int row = row0 + ai * 128 + m * 16;
#pragma unroll
                for (int bj = 0; bj < 2; ++bj) {
                    const int col = col0 + bj * 128; const f32x4 v0 = acc[ai][bj][m][0], v1 = acc[ai][bj][m][1];
                    const u32x4 h = *(const u32x4*)(h0b + (size_t)row * 1024 + col);
                    u32x4 w;
                    w.x = pk_bf16(DN_ALPHA * bf_lo(h.x) + v0[0], DN_ALPHA * bf_hi(h.x) + v0[1]); w.y = pk_bf16(DN_ALPHA * bf_lo(h.y) + v0[2], DN_ALPHA * bf_hi(h.y) + v0[3]);
                    w.z = pk_bf16(DN_ALPHA * bf_lo(h.z) + v1[0], DN_ALPHA * bf_hi(h.z) + v1[1]); w.w = pk_bf16(DN_ALPHA * bf_lo(h.w) + v1[2], DN_ALPHA * bf_hi(h.w) + v1[3]);
                    *(u32x4*)(y1 + (size_t)row * 1024 + col) = w;
                }
            }
    }
};
struct EpiG3 {
    static constexpr bool PERM = true, AFTER_DRAIN = false;
    bf16_t* C; int ldc;
    __device__ __forceinline__ void operator()(const f32x4 (&acc)[2][2][4][2], const pg8::Unit& u, int wr, int wc, int fr, int fq) const {
        const int row0 = u.pm * 256 + wr * 64 + fr, col0 = u.pn * 256 + wc * 32 + 8 * fq;
#pragma unroll
        for (int ai = 0; ai < 2; ++ai)
#pragma unroll
            for (int m = 0; m < 4; ++m) {
                const int row = row0 + ai * 128 + m * 16;
#pragma unroll
                for (int bj = 0; bj < 2; ++bj) {
                    const int col = col0 + bj * 128; const f32x4 v0 = acc[ai][bj][m][0], v1 = acc[ai][bj][m][1];
                    u32x4 w; w.x = pk_bf16(v0[0], v0[1]); w.y = pk_bf16(v0[2], v0[3]); w.z = pk_bf16(v1[0], v1[1]); w.w = pk_bf16(v1[2], v1[3]);
                    *(u32x4*)(C + (size_t)row * ldc + col) = w;
                }
            }
    }
};

constexpr int ATT_HIST = 160, ATT_KEYS = 256 + ATT_HIST, ATT_KSTR = 72  , ATT_VSTR = ATT_KEYS + 8  ;
constexpr int ATT_K_BYTES = ATT_KEYS * ATT_KSTR * 2, ATT_LDS_BYTES = ATT_K_BYTES + 64 * ATT_VSTR * 2;
__device__ void phase_attn(const Params& p, unsigned char* smem) {
    const bf16_t* hcat = (const bf16_t*)(p.ws + WS_HCAT); const bf16_t* vT = (const bf16_t*)(p.ws + WS_VT); bf16_t* mix = (bf16_t*)(p.ws + WS_MIX);
    const int tid = threadIdx.x, lane = tid & 63, wid = tid >> 6, qi = lane & 31, hf = lane >> 5;
    bf16_t* Ks = (bf16_t*)smem; bf16_t* Vs = (bf16_t*)(smem + ATT_K_BYTES);
    for (int item = blockIdx.x; item < 512; item += gridDim.x) {
        const int c = item & 7, bh = item >> 3, b = bh >> 3, h = bh & 7;
        const int q0c = c * 256, lo = (q0c > ATT_HIST) ? q0c - ATT_HIST : 0, nkeys = q0c + 256 - lo;
        const size_t tb = (size_t)b * 2048;
        const int q0 = q0c + wid * 32, t = q0 + qi;
        bf16x8 qf[4];
        { const bf16_t* qrow = hcat + (tb + t) * 1536 + 512 + h * 64 + hf * 8;
#pragma unroll
          for (int s = 0; s < 4; ++s) qf[s] = *(const bf16x8*)(qrow + s * 16); }
        __syncthreads();
        {
            const int cpr = nkeys >> 3;
            u32x4 rk[7], rv[7];
#pragma unroll
            for (int j = 0; j < 7; ++j) { const int i = tid + NTHREADS * j; const int ic = (i < nkeys * 8) ? i : 0; const int key = ic >> 3, ch = ic & 7;
                rk[j] = *(const u32x4*)(hcat + (tb + lo + key) * 1536 + 1024 + h * 64 + ch * 8);
                const int d = ic / cpr, cv = ic - d * cpr;
                rv[j] = *(const u32x4*)(vT + (size_t)(bh * 64 + d) * 2048 + lo + cv * 8); }
#pragma unroll
            for (int j = 0; j < 7; ++j) { const int i = tid + NTHREADS * j; if (i < nkeys * 8) { const int key = i >> 3, ch = i & 7; *(u32x4*)(Ks + key * ATT_KSTR + ch * 8) = rk[j];
                const int d = i / cpr, cv = i - d * cpr; *(u32x4*)(Vs + d * ATT_VSTR + cv * 8) = rv[j]; } }
        }
        __syncthreads();
        f32x16 o0, o1;
#pragma unroll
        for (int r = 0; r < 16; ++r) { o0[r] = 0.f; o1[r] = 0.f; }
        float R = 0.f;
        const bf16_t* vbase = vT + (size_t)(bh * 64 + qi) * 2048 + 4 * hf;
        for (int k0 = q0; k0 >= 0; k0 -= 32) {
            bf16x8 kf[4], vf[2][2];
            if (k0 >= lo) {
                const int kl = k0 - lo;
                const bf16_t* kr = Ks + (kl + qi) * ATT_KSTR + hf * 8;
#pragma unroll
                for (int s = 0; s < 4; ++s) kf[s] = *(const bf16x8*)(kr + s * 16);
#pragma unroll
                for (int db = 0; db < 2; ++db)
#pragma unroll
                    for (int s = 0; s < 2; ++s) { const bf16_t* vr = Vs + (db * 32 + qi) * ATT_VSTR + kl + 16 * s + 4 * hf;
                        const u32x2 l = *(const u32x2*)vr, hh = *(const u32x2*)(vr + 8); u32x4 w; w.x = l.x; w.y = l.y; w.z = hh.x; w.w = hh.y; vf[db][s] = __builtin_bit_cast(bf16x8, w); }
            } else {
                const bf16_t* krow = hcat + (tb + k0 + qi) * 1536 + 1024 + h * 64 + hf * 8;
#pragma unroll
                for (int s = 0; s < 4; ++s) kf[s] = *(const bf16x8*)(krow + s * 16);
#pragma unroll
                for (int db = 0; db < 2; ++db)
#pragma unroll
                    for (int s = 0; s < 2; ++s) { const bf16_t* vr = vbase + (size_t)(db * 32) * 2048 + k0 + 16 * s;
                        const u32x2 l = *(const u32x2*)vr, hh = *(const u32x2*)(vr + 8); u32x4 w; w.x = l.x; w.y = l.y; w.z = hh.x; w.w = hh.y; vf[db][s] = __builtin_bit_cast(bf16x8, w); }
            }
            f32x16 sacc;
#pragma unroll
            for (int r = 0; r < 16; ++r) sacc[r] = 0.f;
#pragma unroll
            for (int s = 0; s < 4; ++s) sacc = __builtin_amdgcn_mfma_f32_32x32x16_bf16(kf[s], qf[s], sacc, 0, 0, 0);
            float zv[16], sfx[16], tot[4], ptot[4], after[4];
            const bool diag = (k0 == q0);
            unsigned vmask = 0xffffu;
            if (diag) { vmask = 0u;
#pragma unroll
                for (int r = 0; r < 16; ++r) vmask |= ((k0 + (r & 3) + 8 * (r >> 2) + 4 * hf) < t) ? (1u << r) : 0u; }
#pragma unroll
            for (int r = 0; r < 16; ++r) {
                const float z2 = sacc[r] * (0.125f * 1.44269504088896341f);
                const float sp2 = fmaxf(z2, 0.f) + __builtin_amdgcn_logf(1.f + __builtin_amdgcn_exp2f(-fabsf(z2)));
                zv[r] = z2; sfx[r] = (vmask >> r) & 1u ? -sp2 : 0.f;
            }
#pragma unroll
            for (int g = 0; g < 4; ++g) {
                sfx[4 * g + 2] += sfx[4 * g + 3]; sfx[4 * g + 1] += sfx[4 * g + 2]; sfx[4 * g] += sfx[4 * g + 1];
                tot[g] = sfx[4 * g];
            }
#pragma unroll
            for (int g = 0; g < 4; ++g) ptot[g] = __shfl_xor(tot[g], 32);
            float run = 0.f;
#pragma unroll
            for (int g = 3; g >= 0; --g) { after[g] = run + (hf == 0 ? ptot[g] : 0.f); run += tot[g] + ptot[g]; }
            unsigned apk[8];
#pragma unroll
            for (int r = 0; r < 16; r += 2) {
                const float e0 = __builtin_amdgcn_exp2f(zv[r] + sfx[r] + (after[r >> 2] + R)), e1 = __builtin_amdgcn_exp2f(zv[r + 1] + sfx[r + 1] + (after[(r + 1) >> 2] + R));
                apk[r >> 1] = pk_bf16((vmask >> r) & 1u ? e0 : 0.f, (vmask >> (r + 1)) & 1u ? e1 : 0.f);
            }
            R += run;
            u32x4 w0, w1; w0.x = apk[0]; w0.y = apk[1]; w0.z = apk[2]; w0.w = apk[3]; w1.x = apk[4]; w1.y = apk[5]; w1.z = apk[6]; w1.w = apk[7];
            const bf16x8 af0 = __builtin_bit_cast(bf16x8, w0), af1 = __builtin_bit_cast(bf16x8, w1);
            o0 = __builtin_amdgcn_mfma_f32_32x32x16_bf16(vf[0][0], af0, o0, 0, 0, 0);
            o0 = __builtin_amdgcn_mfma_f32_32x32x16_bf16(vf[0][1], af1, o0, 0, 0, 0);
            o1 = __builtin_amdgcn_mfma_f32_32x32x16_bf16(vf[1][0], af0, o1, 0, 0, 0);
            o1 = __builtin_amdgcn_mfma_f32_32x32x16_bf16(vf[1][1], af1, o1, 0, 0, 0);
            if (__all(R <= -127.0f)) break;
        }
        bf16_t* orow = mix + (tb + t) * 1024 + 512 + h * 64 + 4 * hf;
#pragma unroll
        for (int g = 0; g < 4; ++g) {
            u32x2 w; w.x = pk_bf16(o0[4 * g], o0[4 * g + 1]); w.y = pk_bf16(o0[4 * g + 2], o0[4 * g + 3]); *(u32x2*)(orow + 8 * g) = w;
            u32x2 w2; w2.x = pk_bf16(o1[4 * g], o1[4 * g + 1]); w2.y = pk_bf16(o1[4 * g + 2], o1[4 * g + 3]); *(u32x2*)(orow + 32 + 8 * g) = w2;
        }
    }
    __syncthreads();
}

template <int W> __device__ __forceinline__ void pool_item(const bf16_t* hcat, bf16_t* pooled, int t, int c8) {
    const int s = t & 2047, cnt = (s + 1 < W) ? (s + 1) : W;
    u32x4 v[W];
#pragma unroll
    for (int i = 0; i < W; ++i) { const int ti = t - ((i < cnt) ? i : (cnt - 1)); v[i] = *(const u32x4*)(hcat + (size_t)ti * 1536 + c8); }
    float acc[8];
#pragma unroll
    for (int j = 0; j < 8; ++j) acc[j] = 0.f;
#pragma unroll
    for (int i = 0; i < W; ++i) {
        const float wgt = (i < cnt) ? 1.f : 0.f;
        acc[0] += wgt * bf_lo(v[i].x); acc[1] += wgt * bf_hi(v[i].x); acc[2] += wgt * bf_lo(v[i].y); acc[3] += wgt * bf_hi(v[i].y);
        acc[4] += wgt * bf_lo(v[i].z); acc[5] += wgt * bf_hi(v[i].z); acc[6] += wgt * bf_lo(v[i].w); acc[7] += wgt * bf_hi(v[i].w);
    }
    const float inv = 1.0f / (float)cnt;
    u32x4 o; o.x = pk_bf16(acc[0] * inv - bf_lo(v[0].x), acc[1] * inv - bf_hi(v[0].x)); o.y = pk_bf16(acc[2] * inv - bf_lo(v[0].y), acc[3] * inv - bf_hi(v[0].y));
    o.z = pk_bf16(acc[4] * inv - bf_lo(v[0].z), acc[5] * inv - bf_hi(v[0].z)); o.w = pk_bf16(acc[6] * inv - bf_lo(v[0].w), acc[7] * inv - bf_hi(v[0].w));
    *(u32x4*)(pooled + (size_t)t * 512 + c8) = o;
}
__device__ void phase_poolprep(const Params& p) {
    const bf16_t* hcat = (const bf16_t*)(p.ws + WS_HCAT); bf16_t* pooled = (bf16_t*)(p.ws + WS_POOLED);
    const int lane = threadIdx.x & 63, wid = threadIdx.x >> 6;
    if (blockIdx.x >= 256) return;
    const int tm = blockIdx.x & 127, bz = blockIdx.x >> 7;
    for (int ii = wid; ii < 64; ii += NWAVES) {
        const int g = 2 * bz + (ii & 1), t = tm * 128 + (ii >> 1) * 4 + (lane >> 4), c8 = g * 128 + (lane & 15) * 8;
        if (g == 0) pool_item<2>(hcat, pooled, t, c8);
        else if (g == 1) pool_item<4>(hcat, pooled, t, c8);
        else if (g == 2) pool_item<8>(hcat, pooled, t, c8);
        else pool_item<16>(hcat, pooled, t, c8);
    }
}

__device__ void phase_ln1(const Params& p) {
    const int lane = threadIdx.x & 63, wid = threadIdx.x >> 6;
    const int gw = blockIdx.x * NWAVES + wid, nw = gridDim.x * NWAVES;
    const bf16_t* y1 = (const bf16_t*)(p.ws + WS_HCAT); bf16_t* x1b = (bf16_t*)(p.ws + WS_H0B);
    f32x4 gg[4], bb[4];
#pragma unroll
    for (int i = 0; i < 4; ++i) { gg[i] = *(const f32x4*)(p.ln1_g + 16 * lane + 4 * i); bb[i] = *(const f32x4*)(p.ln1_b + 16 * lane + 4 * i); }
    for (int r0 = gw; r0 < T_; r0 += 4 * nw) {
        u32x4 raw[4][2];
#pragma unroll
        for (int j = 0; j < 4; ++j) { const int r = min(r0 + j * nw, T_ - 1); raw[j][0] = *(const u32x4*)(y1 + (size_t)r * 1024 + 16 * lane); raw[j][1] = *(const u32x4*)(y1 + (size_t)r * 1024 + 16 * lane + 8); }
#pragma unroll
        for (int j = 0; j < 4; ++j) {
            const int r = r0 + j * nw; if (r >= T_) break;
            float v[16];
#pragma unroll
            for (int h = 0; h < 2; ++h) { v[8 * h] = bf_lo(raw[j][h].x); v[8 * h + 1] = bf_hi(raw[j][h].x); v[8 * h + 2] = bf_lo(raw[j][h].y); v[8 * h + 3] = bf_hi(raw[j][h].y);
                v[8 * h + 4] = bf_lo(raw[j][h].z); v[8 * h + 5] = bf_hi(raw[j][h].z); v[8 * h + 6] = bf_lo(raw[j][h].w); v[8 * h + 7] = bf_hi(raw[j][h].w); }
            float sm = 0.f;
#pragma unroll
            for (int i = 0; i < 16; ++i) sm += v[i];
            const float mean = wave_sum(sm) * (1.0f / 1024.0f);
            float q = 0.f;
#pragma unroll
            for (int i = 0; i < 16; ++i) { const float d = v[i] - mean; q += d * d; }
            const float rstd = rsqrtf(wave_sum(q) * (1.0f / 1024.0f) + LN_EPS);
            u32x4 o[2];
#pragma unroll
            for (int h = 0; h < 2; ++h) {
                float y[8];
#pragma unroll
                for (int i = 0; i < 8; ++i) y[i] = (v[8 * h + i] - mean) * rstd * gg[2 * h + (i >> 2)][i & 3] + bb[2 * h + (i >> 2)][i & 3];
                o[h].x = pk_bf16(y[0], y[1]); o[h].y = pk_bf16(y[2], y[3]); o[h].z = pk_bf16(y[4], y[5]); o[h].w = pk_bf16(y[6], y[7]);
            }
            *(u32x4*)(x1b + (size_t)r * 1024 + 16 * lane) = o[0]; *(u32x4*)(x1b + (size_t)r * 1024 + 16 * lane + 8) = o[1];
        }
    }
}

__device__ __forceinline__ unsigned ord_key(float f) { const unsigned u = __float_as_uint(f); return u ^ ((unsigned)((int)u >> 31) | 0x80000000u); }
__device__ __forceinline__ float ord_val(unsigned k) { const unsigned u = (k & 0x80000000u) ? (k ^ 0x80000000u) : ~k; return __uint_as_float(u); }

#define TK_CE(x, a, b) do { const unsigned hi_ = max((x)[a], (x)[b]), lo_ = min((x)[a], (x)[b]); (x)[a] = hi_; (x)[b] = lo_; } while (0)
template <int N> __device__ __forceinline__ void tk_merge_desc(unsigned (&x)[N]) {
#pragma unroll
    for (int k = N / 2; k >= 1; k >>= 1)
#pragma unroll
        for (int i = 0; i < N; ++i) if ((i & k) == 0) TK_CE(x, i, i | k);
}
template <int N> __device__ __forceinline__ void tk_sort_desc(unsigned (&x)[N]) {
#pragma unroll
    for (int sz = 2; sz <= N; sz <<= 1)
#pragma unroll
        for (int k = sz >> 1; k >= 1; k >>= 1)
#pragma unroll
            for (int i = 0; i < N; ++i) { const int l = i ^ k; if (l > i) { if ((i & sz) == 0) TK_CE(x, i, l); else TK_CE(x, l, i); } }
}
__device__ __forceinline__ void tk_top16(const unsigned (&a)[16], const unsigned (&b)[16], unsigned (&o)[16]) {
#pragma unroll
    for (int i = 0; i < 16; ++i) o[i] = max(a[i], b[15 - i]);
    tk_merge_desc<16>(o);
}

__device__ void phase_topk(const Params& p, unsigned char* smem) {
    const bf16_t* qp = (const bf16_t*)(p.ws + WS_HCAT); const bf16_t* subk = (const bf16_t*)(p.ws + WS_SUBK);
    int* idx = (int*)(p.ws + WS_MIX); float* gate = (float*)(p.ws + WS_MIX + 8 * MB); float* ginv = (float*)(p.ws + WS_MIX + 16 * MB);
    const int gw = blockIdx.x * NWAVES + ((int)threadIdx.x >> 6), nw = gridDim.x * NWAVES;
    constexpr int SK_STRIDE = 272, SK_BYTES = 256 * SK_STRIDE;
    {
        const int tid0 = threadIdx.x;
#pragma unroll
        for (int i = 0; i < 8; ++i) { const int c = tid0 + 512 * i, row = c >> 4, ch = c & 15;
            *(u32x4*)(smem + row * SK_STRIDE + ch * 16) = *(const u32x4*)(subk + (size_t)row * 128 + ch * 8); }
        __syncthreads();
    }
    for (int item = gw; item < 4096; item += nw) {
        int tid = threadIdx.x; asm volatile("" : "+v"(tid));
        const int lane = tid & 63, qi = lane & 31, hf = lane >> 5;
        const int R = item * 32 + qi;
        unsigned hf4 = (unsigned)hf << 2; asm volatile("" : "+v"(hf4));
        unsigned sel[2][16];
        bf16x8 qfa[2][8];
#pragma unroll
        for (int pp = 0; pp < 2; ++pp) { const bf16_t* qrow = qp + (size_t)R * 256 + pp * 128 + hf * 8;
#pragma unroll
            for (int s = 0; s < 8; ++s) qfa[pp][s] = *(const bf16x8*)(qrow + s * 16); }
#pragma unroll
        for (int pp = 0; pp < 2; ++pp) {
            bf16x8 qf[8];
#pragma unroll
            for (int s = 0; s < 8; ++s) qf[s] = qfa[pp][s];
            unsigned g[4][16];
#pragma unroll
            for (int nb = 0; nb < 4; ++nb) {
                f32x16 sc;
#pragma unroll
                for (int r = 0; r < 16; ++r) sc[r] = 0.f;
                const unsigned char* krow = smem + (pp * 128 + nb * 32 + qi) * SK_STRIDE + hf * 16;
#pragma unroll
                for (int s = 0; s < 8; ++s) { const bf16x8 kf = *(const bf16x8*)(krow + s * 32); sc = __builtin_amdgcn_mfma_f32_32x32x16_bf16(kf, qf[s], sc, 0, 0, 0); }
#pragma unroll
                for (int r = 0; r < 16; ++r) { const unsigned nbase = (unsigned)(nb * 32 + (r & 3) + 8 * (r >> 2)); g[nb][r] = ((ord_key(sc[r]) & 0xFFFFFF80u) | (127u ^ nbase)) ^ hf4; }
                tk_sort_desc<16>(g[nb]);
                __builtin_amdgcn_sched_barrier(0);
            }
            unsigned m01[16], m23[16], m[16], u[16];
            tk_top16(g[0], g[1], m01); tk_top16(g[2], g[3], m23); tk_top16(m01, m23, m);
#pragma unroll
            for (int i = 0; i < 16; ++i) u[i] = max(m[i], (unsigned)__shfl_xor((int)m[15 - i], 32));
            tk_merge_desc<16>(u);
#pragma unroll
            for (int i = 0; i < 16; ++i) sel[pp][i] = u[i];
            __builtin_amdgcn_sched_barrier(0);
        }
        float av[16], bv[16]; unsigned anb[4] = {0u, 0u, 0u, 0u}, bnb[4] = {0u, 0u, 0u, 0u};
#pragma unroll
        for (int i = 0; i < 16; ++i) { av[i] = ord_val(sel[0][i] & 0xFFFFFF80u); bv[i] = ord_val(sel[1][i] & 0xFFFFFF80u);
            anb[i >> 2] |= (127u - (sel[0][i] & 127u)) << (8 * (i & 3)); bnb[i >> 2] |= (127u - (sel[1][i] & 127u)) << (8 * (i & 3)); }
        unsigned char* tb = smem + SK_BYTES + (tid >> 6) * 2048 + lane * 32;
        *(u32x4*)tb = (u32x4){anb[0], anb[1], anb[2], anb[3]}; *(u32x4*)(tb + 16) = (u32x4){bnb[0], bnb[1], bnb[2], bnb[3]};
#define TK_CK(i, j) ((ord_key(av[i] + bv[j]) & 0xFFFFFF00u) | (unsigned)(255 - ((i) * 16 + (j))))
        unsigned cA[16], cB[16], cC[16], cD[16], m1[16], m2[16], best[16];
#pragma unroll
        for (int i = 0; i < 16; ++i) { cA[i] = TK_CK(i, 0); cB[i] = (i < 15) ? TK_CK(0, i + 1) : 0u; cD[i] = 0u; }
        cC[0] = TK_CK(1, 1); cC[1] = TK_CK(1, 2); cC[2] = TK_CK(1, 3); cC[3] = TK_CK(1, 4); cC[4] = TK_CK(1, 5); cC[5] = TK_CK(1, 6); cC[6] = TK_CK(1, 7);
        cC[7] = TK_CK(2, 1); cC[8] = TK_CK(2, 2); cC[9] = TK_CK(2, 3); cC[10] = TK_CK(2, 4);
        cC[11] = TK_CK(3, 1); cC[12] = TK_CK(3, 2); cC[13] = TK_CK(3, 3); cC[14] = TK_CK(4, 1); cC[15] = TK_CK(4, 2);
        cD[0] = TK_CK(5, 1); cD[1] = TK_CK(6, 1); cD[2] = TK_CK(7, 1);
#undef TK_CK
        tk_sort_desc<16>(cC);
        tk_top16(cA, cB, m1); tk_top16(cC, cD, m2); tk_top16(m1, m2, best);
        const float s0 = ord_val(best[0] & 0xFFFFFF00u);
        float ex[16], sum = 0.f; int eo[16];
#pragma unroll
        for (int k = 0; k < 16; ++k) {
            const unsigned pos = 255u - (best[k] & 255u);
            ex[k] = __expf(ord_val(best[k] & 0xFFFFFF00u) - s0); sum += ex[k];
            eo[k] = (int)tb[pos >> 4] * 128 + (int)tb[16 + (pos & 15)];
        }
        if (hf == 0) {
#pragma unroll
            for (int k = 0; k < 16; k += 4) {
                *(int4*)(idx + (size_t)R * 16 + k) = make_int4(eo[k], eo[k + 1], eo[k + 2], eo[k + 3]);
                *(f32x4*)(gate + (size_t)R * 16 + k) = (f32x4){ex[k], ex[k + 1], ex[k + 2], ex[k + 3]};
            }
            ginv[R] = 1.0f / sum;
        }
#pragma unroll 1
        for (int j = 0; j < 8; j += 4) convert_table_rows4(p, item * 8 + j, lane);
    }
}

typedef __bf16 bf16x2v __attribute__((ext_vector_type(2)));
constexpr int G2_XT_BYTES = 64 * 2048;
constexpr int G2_LIST_OFF = G2_XT_BYTES;
constexpr int G2_LDS_BYTES = G2_XT_BYTES + 8 * 1024 * 4;
constexpr int G2V_ACT_OFF = 96 * 1024;
constexpr int G2V_HILO = 0;
typedef int i32x2 __attribute__((ext_vector_type(2)));
constexpr size_t WS_ACT = WS_POOLED;
__device__ __forceinline__ unsigned g2_key(unsigned ent) { return ((ent >> 26) << 3) | ((ent >> 14) & 7u); }

__device__ __forceinline__ float gelu_as(float v) {
    const float av = fabsf(v), t = __builtin_amdgcn_rcpf(av * 0.2316418882f + 1.0f);
    float q = t * 0.5307027145f + (-0.7265760135f); q = q * t + 0.7107068705f; q = q * t + (-0.142248368f); q = q * t + 0.127414796f; q = q * t;
    const float e = __builtin_amdgcn_exp2f((v * v) * (-0.72134752044f));
    const float m = v * (q * e);
    return v < 0.f ? m : v - m;
}
__device__ __forceinline__ void g2u_issue(const unsigned char* u8, int entreg, int base, int lane, u32x4 (&ub)[8]) {
#pragma unroll
    for (int j = 0; j < 8; ++j) { const unsigned roff = (unsigned)__builtin_amdgcn_readlane(entreg, base + j) >> 7 & 0xfffffc00u;
        ub[j] = *(const u32x4*)(u8 + roff + 16 * lane); }
}
__device__ __forceinline__ float g2u_compute(const unsigned char* xw, int entreg, float sureg, float gsreg, int base, int lane, const u32x4 (&ub)[8]) {
    float s[8];
#pragma unroll
    for (int j = 0; j < 8; ++j) {
        const int slot = (__builtin_amdgcn_readlane(entreg, base + j) >> 14) & 7;
        const u32x4 x = *(const u32x4*)(xw + slot * 1024 + 16 * lane);
        int d = 0;
#pragma unroll
        for (int w = 0; w < 4; ++w) d = __builtin_amdgcn_sdot4((int)ub[j][w], (int)x[w], d, false);
        s[j] = (float)d;
    }
    const float q0 = swap16_add(swap32_add(s[0], s[4]), swap32_add(s[2], s[6]));
    const float q1 = swap16_add(swap32_add(s[1], s[5]), swap32_add(s[3], s[7]));
    const bool b3 = (lane & 8) != 0;
    const float keep = b3 ? q1 : q0, send = b3 ? q0 : q1;
    float r = keep + dpp_f<0x128>(send);
    r += dpp_f<0xB1>(r); r += dpp_f<0x4E>(r); r += dpp_f<0x141>(r);
    const float su = __shfl(sureg, base + (lane >> 3)), gs = __shfl(gsreg, base + (lane >> 3));
    const float hid = r * su;
    return gelu_as(hid) * gs;
}

__device__ __forceinline__ void g2v_issue(const unsigned char* vlane, int e, u32x4 (&vb)[8]) {
    const unsigned char* r = vlane + (size_t)e * 1024;
#pragma unroll
    for (int c = 0; c < 8; ++c) vb[c] = *(const u32x4*)(r + c * 128);
}
__device__ __forceinline__ void g2v_compute(f32x2 (&acc)[8][8], float a, const u32x4 (&vb)[8]) {
    const f32x2 a2 = {a, a};
#pragma unroll
    for (int c = 0; c < 8; ++c)
#pragma unroll
        for (int w = 0; w < 4; ++w) {
            const f32x2 lo = __builtin_amdgcn_cvt_pk_f32_fp8((int)vb[c][w], false), hi = __builtin_amdgcn_cvt_pk_f32_fp8((int)vb[c][w], true);
            asm("v_pk_fma_f32 %0, %1, %2, %0" : "+v"(acc[c][2 * w]) : "v"(a2), "v"(lo));
            asm("v_pk_fma_f32 %0, %1, %2, %0" : "+v"(acc[c][2 * w + 1]) : "v"(a2), "v"(hi));
        }
}

__device__ void phase_gather2(const Params& p, unsigned char* smem) {
    const unsigned char* u8 = p.ws + WS_U8; const unsigned char* v8 = p.ws + WS_V8;
    const float* su = (const float*)(p.ws + WS_SU); const float* sv = (const float*)(p.ws + WS_SV);
    const int* idx = (const int*)(p.ws + WS_MIX); const float* gate = (const float*)(p.ws + WS_MIX + 8 * MB); const float* ginv = (const float*)(p.ws + WS_MIX + 16 * MB);
    const bf16_t* x1b = (const bf16_t*)(p.ws + WS_H0B);
    const int wid = __builtin_amdgcn_readfirstlane((int)threadIdx.x >> 6);
    unsigned* lst = (unsigned*)(smem + G2_LIST_OFF) + wid * 1024;
    unsigned* cnt = (unsigned*)smem + wid * 1024;
    unsigned* bas = cnt + 256;
    {
        const int tile = blockIdx.x; if (tile >= T_ / 64) return;
        const int tid = threadIdx.x, lane = tid & 63;
        const int tok0 = tile * 64, tw = tok0 + wid * 8;
        float* isclg = (float*)(p.ws + WS_ACT) + (size_t)tile * 64;
        float* actl = (float*)(smem + G2V_ACT_OFF) + wid * 1024;
        __syncthreads();
        *(u32x4*)(cnt + 4 * lane) = (u32x4){0u, 0u, 0u, 0u};
        __syncthreads();
        {
            unsigned ent[16], rnk[16];
#pragma unroll
            for (int i = 0; i < 16; ++i) {
                const int slot = i >> 1, k = (i & 1) * 64 + lane;
                const unsigned e = (unsigned)idx[(size_t)(tw + slot) * 128 + k];
                ent[i] = (e << 17) | ((unsigned)slot << 14) | ((unsigned)k << 7);
                rnk[i] = atomicAdd(&cnt[g2_key(ent[i])], 1u);
            }
            __syncthreads();
            {
                const u32x4 c = *(const u32x4*)(cnt + 4 * lane);
                const unsigned tot = c.x + c.y + c.z + c.w; unsigned incl = tot;
#pragma unroll
                for (int o = 1; o < 64; o <<= 1) { const unsigned v = (unsigned)__shfl_up((int)incl, o); if (lane >= o) incl += v; }
                const unsigned ex = incl - tot;
                u32x4 b; b.x = ex; b.y = ex + c.x; b.z = ex + c.x + c.y; b.w = ex + c.x + c.y + c.z;
                *(u32x4*)(bas + 4 * lane) = b;
            }
            __syncthreads();
#pragma unroll
            for (int i = 0; i < 16; ++i) {
                const unsigned key = g2_key(ent[i]);
                lst[bas[key] + rnk[i]] = ent[i];
            }
        }
        __syncthreads();
        unsigned char* xwp = smem + wid * 8 * 1024;
        float* sxw = (float*)(smem + 64 * 1024) + wid * 8;
#pragma unroll 1
        for (int sl = 0; sl < 8; ++sl) {
            const bf16_t* xr = x1b + (size_t)(tw + sl) * 1024 + 16 * lane;
            const u32x4 a = *(const u32x4*)xr, b = *(const u32x4*)(xr + 8);
            const float v[16] = {bf_lo(a.x), bf_hi(a.x), bf_lo(a.y), bf_hi(a.y), bf_lo(a.z), bf_hi(a.z), bf_lo(a.w), bf_hi(a.w), bf_lo(b.x), bf_hi(b.x), bf_lo(b.y), bf_hi(b.y), bf_lo(b.z), bf_hi(b.z), bf_lo(b.w), bf_hi(b.w)};
            float amax = 0.f;
#pragma unroll
            for (int i = 0; i < 16; ++i) amax = fmaxf(amax, fabsf(v[i]));
#pragma unroll
            for (int o = 32; o > 0; o >>= 1) amax = fmaxf(amax, __shfl_xor(amax, o));
            const float sc = amax > 0.f ? 127.0f / amax : 1.0f;
            u32x4 w;
#pragma unroll
            for (int i = 0; i < 4; ++i) w[i] = q8x4(v[4 * i] * sc, v[4 * i + 1] * sc, v[4 * i + 2] * sc, v[4 * i + 3] * sc);
            *(u32x4*)(xwp + sl * 1024 + 16 * lane) = w;
            if (lane == 0) sxw[sl] = amax > 0.f ? amax * (1.0f / 127.0f) : 1.0f;
        }
        {
            const unsigned char* xw = xwp;
            int entA = (int)lst[lane];
            float suA, gsA;
            { const int e = entA >> 17, slot = (entA >> 14) & 7, k = (entA >> 7) & 127; const size_t tk = (size_t)(tw + slot);
              suA = su[e] * sxw[slot]; gsA = gate[tk * 128 + k] * ginv[tk * 8 + (k >> 4)] * sv[e]; }
            u32x4 ub0[8], ub1[8], ub2[8], ub3[8];
            g2u_issue(u8, entA, 0, lane, ub0); g2u_issue(u8, entA, 8, lane, ub1); g2u_issue(u8, entA, 16, lane, ub2);
#pragma unroll 1
            for (int chunk = 0; chunk < 16; ++chunk) {
                const bool more = chunk < 15;
                const int entN = (int)lst[(more ? chunk + 1 : chunk) * 64 + lane];
                float suN, gsN;
                { const int e = entN >> 17, slot = (entN >> 14) & 7, k = (entN >> 7) & 127; const size_t tk = (size_t)(tw + slot);
                  suN = su[e] * sxw[slot]; gsN = gate[tk * 128 + k] * ginv[tk * 8 + (k >> 4)] * sv[e]; }
                float actchunk = 0.f;
#define G2U_STEP(J, BC, BN) do { if (J + 3 < 8) g2u_issue(u8, entA, (J + 3) * 8, lane, BN); else if (more) g2u_issue(u8, entN, (J + 3 - 8) * 8, lane, BN); \
                    const float a_ = g2u_compute(xw, entA, suA, gsA, J * 8, lane, BC); const float v_ = __shfl(a_, (lane & 7) * 8); actchunk = ((lane >> 3) == J) ? v_ : actchunk; } while (0)
                G2U_STEP(0, ub0, ub3); G2U_STEP(1, ub1, ub0); G2U_STEP(2, ub2, ub1); G2U_STEP(3, ub3, ub2);
                G2U_STEP(4, ub0, ub3); G2U_STEP(5, ub1, ub0); G2U_STEP(6, ub2, ub1); G2U_STEP(7, ub3, ub2);
#undef G2U_STEP
                actl[chunk * 64 + lane] = actchunk;
                entA = entN; suA = suN; gsA = gsN;
            }
        }
        {
            float am[8];
#pragma unroll
            for (int sI = 0; sI < 8; ++sI) am[sI] = 0.f;
#pragma unroll 1
            for (int ch = 0; ch < 16; ++ch) {
                const unsigned e = lst[ch * 64 + lane]; const float a = fabsf(actl[ch * 64 + lane]); const unsigned sl = (e >> 14) & 7u;
#pragma unroll
                for (int sI = 0; sI < 8; ++sI) am[sI] = fmaxf(am[sI], sl == (unsigned)sI ? a : 0.f);
            }
#pragma unroll
            for (int sI = 0; sI < 8; ++sI) {
#pragma unroll
                for (int o = 32; o > 0; o >>= 1) am[sI] = fmaxf(am[sI], __shfl_xor(am[sI], o));
            }
            float sc[8];
#pragma unroll
            for (int sI = 0; sI < 8; ++sI) sc[sI] = am[sI] > 0.f ? 240.0f / am[sI] : 1.0f;
#pragma unroll 1
            for (int ch = 0; ch < 16; ++ch) {
                const unsigned e = lst[ch * 64 + lane]; const unsigned sl = (e >> 14) & 7u;
                float f = sc[0];
#pragma unroll
                for (int sI = 1; sI < 8; ++sI) f = sl == (unsigned)sI ? sc[sI] : f;
                actl[ch * 64 + lane] *= f;
            }
            float myi = 1.0f;
#pragma unroll
            for (int sI = 0; sI < 8; ++sI) myi = (lane == sI) ? (am[sI] > 0.f ? am[sI] * (1.0f / 240.0f) : 1.0f) : myi;
            if (lane < 8) __hip_atomic_store(isclg + wid * 8 + lane, myi, __ATOMIC_RELAXED, __HIP_MEMORY_SCOPE_AGENT);
        }
        asm volatile("s_waitcnt vmcnt(0) lgkmcnt(0)" ::: "memory");
        __syncthreads();
        f32x4 acc[32];
#pragma unroll
        for (int i = 0; i < 32; ++i) acc[i] = (f32x4){0.f, 0.f, 0.f, 0.f};
        const int g = wid >> 1, h = wid & 1;
        unsigned char* stage = smem + wid * 8192;
        {
            const int m = lane & 15, kq = lane >> 4, sel = kq >> 1;
            const unsigned myslot = ((m >> 3) == sel) ? (unsigned)(m & 7) : 8u;
            const unsigned lbase = (unsigned)((2 * g + sel) * 4096 + (kq & 1) * 32);
            const int rr = lane >> 3, pj = lane & 7;
            const unsigned dcol = (unsigned)(512 * h + 16 * pj);
            const unsigned eoff0 = (unsigned)((2 * g) * 4096 + rr * 4), eoff1 = eoff0 + 32u, eoff2 = eoff0 + 4096u, eoff3 = eoff0 + 4096u + 32u;
            const unsigned char* lsts = smem + G2_LIST_OFF; const unsigned char* acts = smem + G2V_ACT_OFF;
            const unsigned wrE = (unsigned)(pj * 128 + ((rr + pj) & 7) * 16), wrO = (unsigned)((pj ^ 1) * 128 + ((rr + pj) & 7) * 16);
            unsigned rotv[8];
            { const unsigned sb = (unsigned)(size_t)((PG8_LAS unsigned char*)smem) + (unsigned)(wid * 8192 + kq * 1024 + 8 * (m & 1));
#pragma unroll
              for (int jj = 0; jj < 8; ++jj) rotv[jj] = sb + (unsigned)(((jj ^ (kq & 1)) * 128) + ((((m >> 1) + jj) & 7) << 4)); }
            unsigned roC[4], roN[4];
            u32x4 vb[4][4];
#define G2V_ENT(off) (*(const unsigned*)(lsts + (off)))
#define G2V_ROFF(RO, J) do { const unsigned jo_ = 64u * (unsigned)(J); \
                RO[0] = ((G2V_ENT(eoff0 + jo_) >> 7) & 0xfffffc00u) + dcol; RO[1] = ((G2V_ENT(eoff1 + jo_) >> 7) & 0xfffffc00u) + dcol; \
                RO[2] = ((G2V_ENT(eoff2 + jo_) >> 7) & 0xfffffc00u) + dcol; RO[3] = ((G2V_ENT(eoff3 + jo_) >> 7) & 0xfffffc00u) + dcol; } while (0)
#define G2V_LOAD(RO, CQ) do { _Pragma("unroll") for (int kk_ = 0; kk_ < 4; ++kk_) vb[CQ][kk_] = *(const u32x4*)(v8 + RO[kk_] + 128u * (CQ)); } while (0)
#define G2V_TR8(OFS) asm volatile("ds_read_b64_tr_b8 %0, %8 offset:" OFS "\n\tds_read_b64_tr_b8 %1, %9 offset:" OFS "\n\tds_read_b64_tr_b8 %2, %10 offset:" OFS "\n\tds_read_b64_tr_b8 %3, %11 offset:" OFS "\n\t" \
                             "ds_read_b64_tr_b8 %4, %12 offset:" OFS "\n\tds_read_b64_tr_b8 %5, %13 offset:" OFS "\n\tds_read_b64_tr_b8 %6, %14 offset:" OFS "\n\tds_read_b64_tr_b8 %7, %15 offset:" OFS "\n\t" \
                             "s_waitcnt lgkmcnt(0)" \
                             : "=&v"(b_[0]), "=&v"(b_[1]), "=&v"(b_[2]), "=&v"(b_[3]), "=&v"(b_[4]), "=&v"(b_[5]), "=&v"(b_[6]), "=&v"(b_[7]) \
                             : "v"(rotv[0]), "v"(rotv[1]), "v"(rotv[2]), "v"(rotv[3]), "v"(rotv[4]), "v"(rotv[5]), "v"(rotv[6]), "v"(rotv[7]) : "memory")
#define G2V_STEP(CQ) do { unsigned char* sb_ = stage + ((CQ) & 1) * 4096; \
                _Pragma("unroll") for (int kk_ = 0; kk_ < 4; ++kk_) *(u32x4*)(sb_ + kk_ * 1024 + ((kk_ & 1) ? wrO : wrE)) = vb[CQ][kk_]; \
                G2V_LOAD(roN, CQ); \
                i32x2 b_[8]; \
                if ((CQ) & 1) G2V_TR8("4096"); else G2V_TR8("0"); \
                _Pragma("unroll") for (int jj_ = 0; jj_ < 8; ++jj_) { const long bb_ = __builtin_bit_cast(long, b_[jj_]); \
                    acc[8 * (CQ) + jj_] = __builtin_amdgcn_mfma_f32_16x16x32_fp8_fp8(Ahi, bb_, acc[8 * (CQ) + jj_], 0, 0, 0); \
                    if (G2V_HILO) acc[8 * (CQ) + jj_] = __builtin_amdgcn_mfma_f32_16x16x32_fp8_fp8(Alo, bb_, acc[8 * (CQ) + jj_], 0, 0, 0); } } while (0)
            G2V_ROFF(roC, 0);
            G2V_LOAD(roC, 0); __builtin_amdgcn_sched_barrier(0); G2V_LOAD(roC, 1); __builtin_amdgcn_sched_barrier(0); G2V_LOAD(roC, 2); __builtin_amdgcn_sched_barrier(0); G2V_LOAD(roC, 3); __builtin_amdgcn_sched_barrier(0);
#pragma unroll 1
            for (int j = 0; j < 64; ++j) {
                G2V_ROFF(roN, j < 63 ? j + 1 : j);
                long Ahi, Alo;
                {
                    const unsigned o_ = lbase + 64u * (unsigned)j;
                    const u32x4 e0 = *(const u32x4*)(lsts + o_), e1 = *(const u32x4*)(lsts + o_ + 16);
                    const f32x4 a0 = *(const f32x4*)(acts + o_), a1 = *(const f32x4*)(acts + o_ + 16);
                    float v[8];
#pragma unroll
                    for (int t = 0; t < 4; ++t) { v[t] = (((e0[t] >> 14) & 7u) == myslot) ? a0[t] : 0.f; v[4 + t] = (((e1[t] >> 14) & 7u) == myslot) ? a1[t] : 0.f; }
                    int h0 = __builtin_amdgcn_cvt_pk_fp8_f32(v[0], v[1], 0, false); h0 = __builtin_amdgcn_cvt_pk_fp8_f32(v[2], v[3], h0, true);
                    int h1 = __builtin_amdgcn_cvt_pk_fp8_f32(v[4], v[5], 0, false); h1 = __builtin_amdgcn_cvt_pk_fp8_f32(v[6], v[7], h1, true);
                    Ahi = (long)(((unsigned long)(unsigned)h1 << 32) | (unsigned long)(unsigned)h0);
                    const f32x2 d0 = __builtin_amdgcn_cvt_pk_f32_fp8(h0, false), d1 = __builtin_amdgcn_cvt_pk_f32_fp8(h0, true), d2 = __builtin_amdgcn_cvt_pk_f32_fp8(h1, false), d3 = __builtin_amdgcn_cvt_pk_f32_fp8(h1, true);
                    int l0 = __builtin_amdgcn_cvt_pk_fp8_f32(v[0] - d0.x, v[1] - d0.y, 0, false); l0 = __builtin_amdgcn_cvt_pk_fp8_f32(v[2] - d1.x, v[3] - d1.y, l0, true);
                    int l1 = __builtin_amdgcn_cvt_pk_fp8_f32(v[4] - d2.x, v[5] - d2.y, 0, false); l1 = __builtin_amdgcn_cvt_pk_fp8_f32(v[6] - d3.x, v[7] - d3.y, l1, true);
                    Alo = (long)(((unsigned long)(unsigned)l1 << 32) | (unsigned long)(unsigned)l0);
                }
                G2V_STEP(0); G2V_STEP(1); G2V_STEP(2); G2V_STEP(3);
#pragma unroll
                for (int kk = 0; kk < 4; ++kk) roC[kk] = roN[kk];
            }
#undef G2V_ENT
#undef G2V_ROFF
#undef G2V_LOAD
#undef G2V_STEP
#undef G2V_TR8
        }
        {
            const int q = lane >> 4, n = lane & 15;
            float isc[4];
#pragma unroll
            for (int r = 0; r < 4; ++r) isc[r] = __hip_atomic_load(isclg + (2 * g + (q >> 1)) * 8 + 4 * (q & 1) + r, __ATOMIC_RELAXED, __HIP_MEMORY_SCOPE_AGENT);
            f32x4 y[4][8];
#pragma unroll
            for (int r = 0; r < 4; ++r) {
                u32x2 xv[8];
#pragma unroll
                for (int i = 0; i < 8; ++i) xv[i] = *(const u32x2*)(x1b + (size_t)(tok0 + 16 * g + 4 * (i >> 1) + r) * 1024 + 512 * h + 256 * (i & 1) + 4 * lane);
                float* sw = (float*)stage + q * 512 + n;
#pragma unroll
                for (int nt = 0; nt < 32; ++nt) sw[16 * nt] = acc[nt][r] * isc[r];
#pragma unroll
                for (int i = 0; i < 8; ++i) {
                    const f32x4 f = *(const f32x4*)((const float*)stage + i * 256 + 4 * lane);
                    y[r][i][0] = f[0] + DN_ALPHA * bf_lo(xv[i].x); y[r][i][1] = f[1] + DN_ALPHA * bf_hi(xv[i].x);
                    y[r][i][2] = f[2] + DN_ALPHA * bf_lo(xv[i].y); y[r][i][3] = f[3] + DN_ALPHA * bf_hi(xv[i].y);
                }
                __builtin_amdgcn_sched_barrier(0);
            }
            float* red = (float*)(smem + G2V_ACT_OFF) + wid * 1024; const float* redp = (const float*)(smem + G2V_ACT_OFF) + (wid ^ 1) * 1024;
            float sm[4][4];
#pragma unroll
            for (int r = 0; r < 4; ++r)
#pragma unroll
                for (int t = 0; t < 4; ++t) { const f32x4 a = y[r][2 * t], b = y[r][2 * t + 1]; sm[r][t] = wave_sum(((a[0] + a[1]) + (a[2] + a[3])) + ((b[0] + b[1]) + (b[2] + b[3]))); }
            __syncthreads();
            if (lane == 0) {
#pragma unroll
                for (int r = 0; r < 4; ++r)
#pragma unroll
                    for (int t = 0; t < 4; ++t) red[4 * t + r] = sm[r][t];
            }
            __syncthreads();
            float mean[4][4], q2[4][4];
#pragma unroll
            for (int r = 0; r < 4; ++r)
#pragma unroll
                for (int t = 0; t < 4; ++t) {
                    mean[r][t] = (sm[r][t] + redp[4 * t + r]) * (1.0f / 1024.0f);
                    float qq = 0.f;
#pragma unroll
                    for (int u = 0; u < 2; ++u)
#pragma unroll
                        for (int e = 0; e < 4; ++e) { y[r][2 * t + u][e] -= mean[r][t]; qq += y[r][2 * t + u][e] * y[r][2 * t + u][e]; }
                    q2[r][t] = wave_sum(qq);
                }
            if (lane == 0) {
#pragma unroll
                for (int r = 0; r < 4; ++r)
#pragma unroll
                    for (int t = 0; t < 4; ++t) red[16 + 4 * t + r] = q2[r][t];
            }
            __syncthreads();
            f32x4 gg[2], bb[2];
#pragma unroll
            for (int u = 0; u < 2; ++u) { gg[u] = *(const f32x4*)(p.ln2_g + 512 * h + 256 * u + 4 * lane); bb[u] = *(const f32x4*)(p.ln2_b + 512 * h + 256 * u + 4 * lane); }
#pragma unroll
            for (int r = 0; r < 4; ++r)
#pragma unroll
                for (int t = 0; t < 4; ++t) {
                    const float rstd = rsqrtf((q2[r][t] + redp[16 + 4 * t + r]) * (1.0f / 1024.0f) + LN_EPS);
#pragma unroll
                    for (int u = 0; u < 2; ++u)
                        *(f32x4*)(p.out + (size_t)(tok0 + 16 * g + 4 * t + r) * 1024 + 512 * h + 256 * u + 4 * lane) = y[r][2 * t + u] * rstd * gg[u] + bb[u];
                }
        }
    }
}

#define XB_TMO      128
#define XB_XCNT(j)  (256  + 64 * (j))
#define XB_XSUB(j)  (1280 + 64 * (j))
#define XB_XGEN(j)  (2304 + 64 * (j))
#define XB_TOP      3328
#define XB_TOPGEN   3392
#define XCD_BAR_WORDS 3456
#define XB_SPIN_CAP (1u << 18)
#define LAS __attribute__((address_space(3)))
__device__ __forceinline__ unsigned xb_ld(unsigned* p)              { return __hip_atomic_load(p, __ATOMIC_RELAXED, __HIP_MEMORY_SCOPE_AGENT); }
__device__ __forceinline__ unsigned xb_add(unsigned* p, unsigned v) { return __hip_atomic_fetch_add(p, v, __ATOMIC_RELAXED, __HIP_MEMORY_SCOPE_AGENT); }
__device__ __forceinline__ unsigned xb_xcc_id() { return (unsigned)__builtin_amdgcn_s_getreg((3 << 11) | 20) & 0xFu; }
#define XB_SPIN(cond, bar) do { unsigned _sp = 0; while (cond) { __builtin_amdgcn_s_sleep(1); \
    if ((++_sp & 255u) == 0u) { if (xb_ld(&(bar)[XB_TMO])) break; if (_sp > XB_SPIN_CAP) { atomicAdd(&(bar)[XB_TMO], 1u); break; } } } } while (0)
struct XcdBarrier { unsigned* bar; unsigned x; volatile LAS unsigned* st; };
__device__ __forceinline__ XcdBarrier xcd_barrier_post(unsigned* bar, volatile LAS unsigned* st) {
    XcdBarrier b; b.bar = bar; b.x = xb_xcc_id(); b.st = st;
    if (threadIdx.x == 0) (void)xb_add(&bar[XB_XCNT(b.x)], 1u);
    return b;
}
__device__ __forceinline__ void xcd_barrier_complete(unsigned* bar, unsigned x, unsigned& nloc, unsigned& nx) {
    const unsigned G = gridDim.x * gridDim.y * gridDim.z;
    unsigned sum, cnt, mine, sp = 0u;
    for (;;) {
        sum = 0u; cnt = 0u; mine = 0u;
#pragma unroll
        for (unsigned j = 0; j < 16; ++j) { const unsigned c = xb_ld(&bar[XB_XCNT(j)]); sum += c; cnt += (c > 0u) ? 1u : 0u; mine = (j == x) ? c : mine; }
        if (sum == G) break;
        __builtin_amdgcn_s_sleep(1);
        if ((++sp & 255u) == 0u) { if (xb_ld(&bar[XB_TMO])) break; if (sp > XB_SPIN_CAP) { atomicAdd(&bar[XB_TMO], 1u); break; } }
    }
    nloc = mine > 0u ? mine : 1u; nx = cnt > 0u ? cnt : 1u;
}
__device__ __forceinline__ void xcd_barrier(const XcdBarrier& b) {
    asm volatile("s_waitcnt vmcnt(0)" ::: "memory");
    __syncthreads();
    if (threadIdx.x == 0) {
        unsigned* bar = b.bar;
        __builtin_amdgcn_s_waitcnt(0);
        unsigned nloc = b.st[0], nx = b.st[1];
        if (nloc == 0u) { xcd_barrier_complete(bar, b.x, nloc, nx); b.st[0] = nloc; b.st[1] = nx; }
        const unsigned old = xb_add(&bar[XB_XSUB(b.x)], 1u);
        const unsigned gen = old / nloc;
        if (old + 1u == (gen + 1u) * nloc) {
            __builtin_amdgcn_fence(__ATOMIC_RELEASE, "agent");
            asm volatile("s_waitcnt vmcnt(0)" ::: "memory");
            const unsigned og = xb_add(&bar[XB_TOP], 1u);
            const unsigned tg = og / nx;
            if (og + 1u == (tg + 1u) * nx) xb_add(&bar[XB_TOPGEN], 1u);
            else XB_SPIN(xb_ld(&bar[XB_TOPGEN]) == tg, bar);
            __builtin_amdgcn_fence(__ATOMIC_ACQUIRE, "agent");
            xb_add(&bar[XB_XGEN(b.x)], 1u);
            asm volatile("s_waitcnt vmcnt(0)" ::: "memory");
        } else {
            XB_SPIN(xb_ld(&bar[XB_XGEN(b.x)]) == gen, bar);
            __builtin_amdgcn_fence(__ATOMIC_ACQUIRE, "agent");
            asm volatile("s_waitcnt vmcnt(0)" ::: "memory");
        }
    }
    __syncthreads();
}

__device__ __forceinline__ void run_phase(int ph, const Params& p, unsigned char* smem, bool dummy = false, const XcdBarrier* rb = nullptr) {
    if (ph == 0) phase_prep(p, smem);
    if (ph == 1) { pg8::Gemm g{(const bf16_t*)(p.ws + WS_H0B), (const bf16_t*)(p.ws + WS_WIN), T_, 2048, 1024}; pg8::StaticOrder S; S.init(T_, 2048, gridDim.x, blockIdx.x);
        EpiG1 e{(bf16_t*)(p.ws + WS_HCAT), (bf16_t*)(p.ws + WS_VT)}; pg8::gemm_phase((PG8_LAS unsigned char*)smem, g, S, e); }
    if (ph == 2) {
        phase_attn(p, smem); phase_poolprep(p);
        asm volatile("s_waitcnt vmcnt(0)" ::: "memory"); __syncthreads();
        EpiPool e{(bf16_t*)(p.ws + WS_MIX), p.pool_b, p.pool_scale};
        gemm_phase((const bf16_t*)(p.ws + WS_POOLED), 512, 256, (const bf16_t*)(p.ws + WS_POOLW), 256, 65536, T_, 256, 256, 2, e, smem);
    }
    if (ph == 4) { pg8::Gemm g{(const bf16_t*)(p.ws + WS_MIX), (const bf16_t*)(p.ws + WS_WOUT), T_, 1024, 1024}; pg8::StaticOrder S; S.init(T_, 1024, gridDim.x, blockIdx.x);
        EpiG2 e{(const bf16_t*)(p.ws + WS_H0B), (bf16_t*)(p.ws + WS_HCAT)}; pg8::gemm_phase((PG8_LAS unsigned char*)smem, g, S, e); }
    if (ph == 5) phase_ln1(p);
    if (ph == 6) { pg8::Gemm g{(const bf16_t*)(p.ws + WS_H0B), (const bf16_t*)(p.ws + WS_WQ), T_, 2048, 1024}; pg8::StaticOrder S; S.init(T_, 2048, gridDim.x, blockIdx.x);
        EpiG3 e{(bf16_t*)(p.ws + WS_HCAT), 2048}; pg8::gemm_phase((PG8_LAS unsigned char*)smem, g, S, e); }
    if (ph == 7) phase_topk(p, smem);
    if (ph == 8) phase_gather2(p, smem);
}

constexpr int PROBE_PH = -1;
constexpr int LDS_BYTES = G2_LDS_BYTES;
__global__ void __launch_bounds__(NTHREADS, 2) k_mega(Params p) {
    extern __shared__ __attribute__((aligned(16))) unsigned char smem[];
    volatile LAS unsigned* st = (volatile LAS unsigned*)(smem + LDS_BYTES - 16);
    if (threadIdx.x < 4) st[threadIdx.x] = 0u;
    __syncthreads();
    const XcdBarrier bar = xcd_barrier_post((unsigned*)(p.ws + WS_CTL), st);
    if (PROBE_PH == 0) run_phase(0, p, smem, true);
    run_phase(0, p, smem); xcd_barrier(bar);
    if (PROBE_PH == 1) run_phase(1, p, smem, true);
    run_phase(1, p, smem); xcd_barrier(bar);
    if (PROBE_PH == 2) run_phase(2, p, smem, true);
    run_phase(2, p, smem); xcd_barrier(bar);
    if (PROBE_PH == 4) run_phase(4, p, smem, true);
    run_phase(4, p, smem); xcd_barrier(bar);
    if (PROBE_PH == 5) run_phase(5, p, smem, true);
    run_phase(5, p, smem); xcd_barrier(bar);
    if (PROBE_PH == 6) run_phase(6, p, smem, true);
    run_phase(6, p, smem); xcd_barrier(bar);
    if (PROBE_PH == 7) run_phase(7, p, smem, true);
    run_phase(7, p, smem); xcd_barrier(bar);
    if (PROBE_PH == 8) run_phase(8, p, smem, true);
    run_phase(8, p, smem, false, nullptr);
}

extern "C" void kernel_launch(void* const* d_in, const int* in_sizes, int n_in, void* d_out, int out_size, void* d_ws, size_t ws_size, hipStream_t stream) {
    if (n_in != 16 || out_size != T_ * D_ || ws_size < WS_END) {
        fprintf(stderr, "kernel_launch: unexpected problem (n_in %d, out %d, ws %zu < %zu)\n", n_in, out_size, ws_size, (size_t)WS_END);
        return;
    }
    static int grid_blocks = 0;
    if (!grid_blocks) {
        int dev = 0, cus = 0, per_cu = 0;
        hipGetDevice(&dev);
        hipDeviceGetAttribute(&cus, hipDeviceAttributeMultiprocessorCount, dev);
        if (hipFuncSetAttribute((const void*)k_mega, hipFuncAttributeMaxDynamicSharedMemorySize, LDS_BYTES) != hipSuccess) { fprintf(stderr, "kernel_launch: hipFuncSetAttribute failed\n"); grid_blocks = -1; return; }
        (void)hipOccupancyMaxActiveBlocksPerMultiprocessor(&per_cu, (const void*)k_mega, NTHREADS, LDS_BYTES);
        if (per_cu < 1) { fprintf(stderr, "kernel_launch: occupancy query says %d blocks per CU\n", per_cu); grid_blocks = -1; }
        else grid_blocks = cus;
    }
    if (grid_blocks < 0) return;
    Params p{};
    p.x = (const float*)d_in[0]; p.ln0_g = (const float*)d_in[1]; p.ln0_b = (const float*)d_in[2]; p.w_in = (const float*)d_in[3];
    p.pool_w = (const float*)d_in[4]; p.pool_b = (const float*)d_in[5]; p.pool_scale = (const float*)d_in[6]; p.w_out = (const float*)d_in[7];
    p.ln1_g = (const float*)d_in[8]; p.ln1_b = (const float*)d_in[9]; p.wq = (const float*)d_in[10]; p.subk = (const float*)d_in[11];
    p.pu = (const float*)d_in[12]; p.pv = (const float*)d_in[13]; p.ln2_g = (const float*)d_in[14]; p.ln2_b = (const float*)d_in[15];
    p.out = (float*)d_out; p.ws = (unsigned char*)d_ws;
    (void)hipMemsetAsync((unsigned char*)d_ws + WS_CTL, 0, 16384, stream);
    void* args[] = {&p};
    hipError_t e = hipLaunchCooperativeKernel((const void*)k_mega, dim3(grid_blocks), dim3(NTHREADS), args, LDS_BYTES, stream);
    if (e != hipSuccess) fprintf(stderr, "kernel_launch: cooperative launch failed: %s (grid %d)\n", hipGetErrorString(e), grid_blocks);
}
```

```cpp
#include <hip/hip_runtime.h>
#include <hip/hip_cooperative_groups.h>
#include <cstdio>
#include <cstdint>

namespace cg = cooperative_groups;

typedef unsigned short bf16_t;
typedef short bf16x8 __attribute__((ext_vector_type(8)));
typedef float f32x4 __attribute__((ext_vector_type(4)));
typedef float f32x16 __attribute__((ext_vector_type(16)));
typedef unsigned u32x4 __attribute__((ext_vector_type(4)));
typedef unsigned u32x2 __attribute__((ext_vector_type(2)));

constexpr int T_ = 16384, D_ = 1024, S_ = 2048;
constexpr int NTHREADS = 512, NWAVES = 8;
constexpr float LN_EPS = 1e-5f;
constexpr float DN_ALPHA = 1.189207115002721f;

constexpr size_t MB = 1024 * 1024;
constexpr size_t WS_CTL = 0;
constexpr size_t WS_H0B = 64 * 1024;
constexpr size_t WS_WIN = WS_H0B + 32 * MB;
constexpr size_t WS_WOUT = WS_WIN + 4 * MB;
constexpr size_t WS_WQ = WS_WOUT + 2 * MB;
constexpr size_t WS_POOLW = WS_WQ + 4 * MB;
constexpr size_t WS_SUBK = WS_POOLW + 256 * 1024;
constexpr size_t WS_UB = WS_SUBK + 64 * 1024;
constexpr size_t WS_U8 = WS_UB, WS_V8 = WS_UB + 16 * MB;
constexpr size_t WS_VB = WS_UB + 32 * MB;
constexpr size_t WS_SU = WS_VB, WS_SV = WS_VB + 64 * 1024;
constexpr size_t WS_HCAT = WS_VB + 32 * MB;
constexpr size_t WS_VT = WS_HCAT + 48 * MB;
constexpr size_t WS_MIX = WS_VT + 16 * MB;
constexpr size_t WS_POOLED = WS_MIX + 32 * MB;
constexpr size_t WS_END = WS_POOLED + 16 * MB;

struct Params {
    const float *x, *ln0_g, *ln0_b, *w_in, *pool_w, *pool_b, *pool_scale, *w_out, *ln1_g, *ln1_b, *wq, *subk, *pu, *pv, *ln2_g, *ln2_b;
    float* out;
    unsigned char* ws;
};

typedef float f32x2 __attribute__((ext_vector_type(2)));
typedef __bf16 bf16x2n __attribute__((ext_vector_type(2)));
__device__ __forceinline__ unsigned pk_bf16(float lo, float hi) { const f32x2 v = {lo, hi}; return __builtin_bit_cast(unsigned, __builtin_convertvector(v, bf16x2n)); }
__device__ __forceinline__ bf16_t f2bf(float f) { return (bf16_t)(pk_bf16(f, 0.f) & 0xffffu); }
__device__ __forceinline__ float bf_lo(unsigned u) { return __uint_as_float(u << 16); }
__device__ __forceinline__ float bf_hi(unsigned u) { return __uint_as_float(u & 0xffff0000u); }
template <int CTRL> __device__ __forceinline__ float dpp_f(float x) { return __int_as_float(__builtin_amdgcn_update_dpp(0, __float_as_int(x), CTRL, 0xF, 0xF, true)); }
__device__ __forceinline__ float row_sum16(float x) { x += dpp_f<0x128>(x); x += dpp_f<0x124>(x); x += dpp_f<0x122>(x); x += dpp_f<0x121>(x); return x; }
__device__ __forceinline__ float swap16_add(float a, float b) { const auto q = __builtin_amdgcn_permlane16_swap(__float_as_uint(a), __float_as_uint(b), false, false); return __uint_as_float(q[0]) + __uint_as_float(q[1]); }
__device__ __forceinline__ float swap32_add(float a, float b) { const auto q = __builtin_amdgcn_permlane32_swap(__float_as_uint(a), __float_as_uint(b), false, false); return __uint_as_float(q[0]) + __uint_as_float(q[1]); }
__device__ __forceinline__ float wave_sum(float v) { v = row_sum16(v); v = swap16_add(v, v); return swap32_add(v, v); }

__device__ __forceinline__ void ln_row(const float* src, const float* g, const float* b, float* dst32, bf16_t* dst16, int lane) {
    f32x4 v[4];
    float s = 0.f;
#pragma unroll
    for (int i = 0; i < 4; ++i) { v[i] = *(const f32x4*)(src + lane * 4 + i * 256); s += (v[i][0] + v[i][1]) + (v[i][2] + v[i][3]); }
    const float mean = wave_sum(s) * (1.0f / 1024.0f);
    float q = 0.f;
#pragma unroll
    for (int i = 0; i < 4; ++i) { f32x4 d = v[i] - mean; q += (d[0] * d[0] + d[1] * d[1]) + (d[2] * d[2] + d[3] * d[3]); }
    const float rstd = rsqrtf(wave_sum(q) * (1.0f / 1024.0f) + LN_EPS);
#pragma unroll
    for (int i = 0; i < 4; ++i) {
        const f32x4 gg = *(const f32x4*)(g + lane * 4 + i * 256), bb = *(const f32x4*)(b + lane * 4 + i * 256);
        const f32x4 y = (v[i] - mean) * rstd * gg + bb;
        if (dst32) *(f32x4*)(dst32 + lane * 4 + i * 256) = y;
        if (dst16) { u32x2 o; o.x = pk_bf16(y[0], y[1]); o.y = pk_bf16(y[2], y[3]); *(u32x2*)(dst16 + lane * 4 + i * 256) = o; }
    }
}

__device__ __forceinline__ void ln_rows4(const float* src, size_t rstride, const float* g, const float* b, bf16_t* dst16, int lane) {
    f32x4 v[4][4];
#pragma unroll
    for (int j = 0; j < 4; ++j)
#pragma unroll
        for (int i = 0; i < 4; ++i) v[j][i] = *(const f32x4*)(src + j * rstride + lane * 4 + i * 256);
    f32x4 gg[4], bb[4];
#pragma unroll
    for (int i = 0; i < 4; ++i) { gg[i] = *(const f32x4*)(g + lane * 4 + i * 256); bb[i] = *(const f32x4*)(b + lane * 4 + i * 256); }
#pragma unroll
    for (int j = 0; j < 4; ++j) {
        float s = 0.f;
#pragma unroll
        for (int i = 0; i < 4; ++i) s += (v[j][i][0] + v[j][i][1]) + (v[j][i][2] + v[j][i][3]);
        const float mean = wave_sum(s) * (1.0f / 1024.0f);
        float q = 0.f;
#pragma unroll
        for (int i = 0; i < 4; ++i) { const f32x4 d = v[j][i] - mean; q += (d[0] * d[0] + d[1] * d[1]) + (d[2] * d[2] + d[3] * d[3]); }
        const float rstd = rsqrtf(wave_sum(q) * (1.0f / 1024.0f) + LN_EPS);
#pragma unroll
        for (int i = 0; i < 4; ++i) {
            const f32x4 y = (v[j][i] - mean) * rstd * gg[i] + bb[i];
            u32x2 o; o.x = pk_bf16(y[0], y[1]); o.y = pk_bf16(y[2], y[3]); *(u32x2*)(dst16 + j * rstride + lane * 4 + i * 256) = o;
        }
    }
}

__device__ __forceinline__ void transpose_tile_wave(const float* W, int N, int k0, int n0, bf16_t* Wt, int ldt, int nout0, int kout0, float* tile  , int lane) {
    float v[64];
#pragma unroll
    for (int k = 0; k < 64; ++k) v[k] = W[(size_t)(k0 + k) * N + n0 + lane];
#pragma unroll
    for (int k = 0; k < 64; ++k) tile[k * 65 + lane] = v[k];
    asm volatile("s_waitcnt lgkmcnt(0)" ::: "memory");
#pragma unroll
    for (int n = 0; n < 64; ++n) Wt[(size_t)(nout0 + n) * ldt + kout0 + lane] = f2bf(tile[lane * 65 + n]);
    asm volatile("s_waitcnt lgkmcnt(0)" ::: "memory");
}

__device__ __forceinline__ unsigned q8x4(float a, float b, float c, float d) {
    unsigned w = 0;
    w = __builtin_amdgcn_cvt_pk_u8_f32(__builtin_rintf(a) + 128.f, 0, w); w = __builtin_amdgcn_cvt_pk_u8_f32(__builtin_rintf(b) + 128.f, 1, w);
    w = __builtin_amdgcn_cvt_pk_u8_f32(__builtin_rintf(c) + 128.f, 2, w); w = __builtin_amdgcn_cvt_pk_u8_f32(__builtin_rintf(d) + 128.f, 3, w);
    return w ^ 0x80808080u;
}
__device__ __forceinline__ void convert_table_rows4(const Params& p, int r0, int lane) {
    const int tbl = r0 >> 14, row0 = r0 & 16383;
    const float* src = (tbl ? p.pv : p.pu) + (size_t)row0 * 1024 + 4 * lane;
    f32x4 v[4][4];
#pragma unroll
    for (int j = 0; j < 4; ++j)
#pragma unroll
        for (int i = 0; i < 4; ++i) v[j][i] = *(const f32x4*)(src + (size_t)j * 1024 + 256 * i);
#pragma unroll
    for (int j = 0; j < 4; ++j) {
        float amax = 0.f;
#pragma unroll
        for (int i = 0; i < 4; ++i) amax = fmaxf(amax, fmaxf(fmaxf(fabsf(v[j][i][0]), fabsf(v[j][i][1])), fmaxf(fabsf(v[j][i][2]), fabsf(v[j][i][3]))));
#pragma unroll
        for (int o = 32; o > 0; o >>= 1) amax = fmaxf(amax, __shfl_xor(amax, o));
        const float top = tbl ? 416.0f : 127.0f;
        const float sc = amax > 0.f ? top / amax : 1.0f, inv = amax > 0.f ? amax / top : 1.0f;
        u32x4 w;
        if (tbl) {
#pragma unroll
            for (int i = 0; i < 4; ++i) { int t = __builtin_amdgcn_cvt_pk_fp8_f32(v[j][i][0] * sc, v[j][i][1] * sc, 0, false); t = __builtin_amdgcn_cvt_pk_fp8_f32(v[j][i][2] * sc, v[j][i][3] * sc, t, true); w[i] = (unsigned)t; }
        } else {
#pragma unroll
            for (int i = 0; i < 4; ++i) w[i] = q8x4(v[j][i][0] * sc, v[j][i][1] * sc, v[j][i][2] * sc, v[j][i][3] * sc);
        }
#pragma unroll
        for (int i = 0; i < 4; ++i) *(unsigned*)(p.ws + (tbl ? WS_V8 : WS_U8) + (size_t)(row0 + j) * 1024 + 256 * i + 4 * lane) = w[i];
        if (lane == 0) ((float*)(p.ws + (tbl ? WS_SV : WS_SU)))[row0 + j] = inv;
    }
}

__device__ void phase_prep(const Params& p, unsigned char* smem) {
    const int tid = threadIdx.x, lane = tid & 63, wid = tid >> 6;
    const int gw = blockIdx.x * NWAVES + wid, nw = gridDim.x * NWAVES;
    const size_t gtid = (size_t)blockIdx.x * NTHREADS + tid, nthr = (size_t)gridDim.x * NTHREADS;
    bf16_t* h0b = (bf16_t*)(p.ws + WS_H0B);
    for (int r = gw; r + 3 * nw < T_; r += 4 * nw) ln_rows4(p.x + (size_t)r * D_, (size_t)nw * D_, p.ln0_g, p.ln0_b, h0b + (size_t)r * D_, lane);
    if (T_ % (4 * nw) != 0) for (int r = gw + (T_ / (4 * nw)) * 4 * nw; r < T_; r += nw) ln_row(p.x + (size_t)r * D_, p.ln0_g, p.ln0_b, nullptr, h0b + (size_t)r * D_, lane);
    {
        u32x2* sk = (u32x2*)(p.ws + WS_SUBK);
        for (size_t i = gtid; i < 2 * 128 * 128 / 4; i += nthr) { const f32x4 a = ((const f32x4*)p.subk)[i]; u32x2 o; o.x = pk_bf16(a[0], a[1]); o.y = pk_bf16(a[2], a[3]); sk[i] = o; }
        bf16_t* pw = (bf16_t*)(p.ws + WS_POOLW);
        for (size_t i = gtid; i < 2 * 2 * 128 * 128; i += nthr) {
            const int half = (int)(i >> 15), blk = (int)((i >> 14) & 1), r = (int)((i >> 7) & 127), c = (int)(i & 127);
            pw[(size_t)half * 65536 + (size_t)(blk * 128 + r) * 256 + ((1 - blk) * 128 + c)] = 0;
        }
    }
    float* tile = (float*)smem + wid * (64 * 65);
    constexpr int T_IN = 16 * 32, T_OUT = 16 * 16, T_Q = 16 * 32, T_POOL = 16;
    for (int it = gw; it < T_IN + T_OUT + T_Q + T_POOL; it += nw) {
        if (it < T_IN) { const int kt = it >> 5, nt = it & 31; transpose_tile_wave(p.w_in, 2048, kt * 64, nt * 64, (bf16_t*)(p.ws + WS_WIN), 1024, nt * 64, kt * 64, tile, lane); }
        else if (it < T_IN + T_OUT) { const int j = it - T_IN, kt = j >> 4, nt = j & 15; transpose_tile_wave(p.w_out, 1024, kt * 64, nt * 64, (bf16_t*)(p.ws + WS_WOUT), 1024, nt * 64, kt * 64, tile, lane); }
        else if (it < T_IN + T_OUT + T_Q) { const int j = it - T_IN - T_OUT, kt = j >> 5, nt = j & 31; transpose_tile_wave(p.wq, 2048, kt * 64, nt * 64, (bf16_t*)(p.ws + WS_WQ), 1024, nt * 64, kt * 64, tile, lane); }
        else { const int j = it - T_IN - T_OUT - T_Q, g = j >> 2, kt = (j >> 1) & 1, nt = j & 1, half = g >> 1, gg = g & 1;
            transpose_tile_wave(p.pool_w + (size_t)g * 128 * 128, 128, kt * 64, nt * 64, (bf16_t*)(p.ws + WS_POOLW) + (size_t)half * 65536, 256, gg * 128 + nt * 64, gg * 128 + kt * 64, tile, lane); }
    }
}

constexpr int BM = 128, BN = 256, BK = 64, LDT = 72;
constexpr int GEMM_LDS_BYTES = (BM + BN) * LDT * 2;

template <class Epi>
__device__ void gemm_phase(const bf16_t* A, int lda, long strideA, const bf16_t* Bt, int ldb, long strideB, int M, int N, int K, int nbatch, const Epi& epi, unsigned char* smem) {
    bf16_t* As = (bf16_t*)smem; bf16_t* Bs = As + BM * LDT;
    const int tid = threadIdx.x, lane = tid & 63, wid = tid >> 6, wr = wid >> 2, wc = wid & 3, fr = lane & 15, fq = lane >> 4;
    const int ntm = M / BM, ntn = N / BN, tiles_per = ntm * ntn, total = tiles_per * nbatch, nk = K / BK;
    const int lrow = tid >> 3, lch = tid & 7;
    for (int tile = blockIdx.x; tile < total; tile += gridDim.x) {
        const int bz = tile / tiles_per, tt = tile - bz * tiles_per, tm = tt / ntn, tn = tt - tm * ntn;
        const bf16_t* Ab = A + (size_t)bz * strideA + (size_t)(tm * BM + lrow) * lda + lch * 8;
        const bf16_t* Bb = Bt + (size_t)bz * strideB + (size_t)(tn * BN + lrow) * ldb + lch * 8;
        u32x4 ra[2], rb[4];
#pragma unroll
        for (int i = 0; i < 2; ++i) ra[i] = *(const u32x4*)(Ab + (size_t)(64 * i) * lda);
#pragma unroll
        for (int i = 0; i < 4; ++i) rb[i] = *(const u32x4*)(Bb + (size_t)(64 * i) * ldb);
        f32x4 acc[4][4];
#pragma unroll
        for (int m = 0; m < 4; ++m)
#pragma unroll
            for (int n = 0; n < 4; ++n) acc[m][n] = (f32x4){0.f, 0.f, 0.f, 0.f};
        for (int kt = 0; kt < nk; ++kt) {
            __syncthreads();
#pragma unroll
            for (int i = 0; i < 2; ++i) *(u32x4*)(As + (lrow + 64 * i) * LDT + lch * 8) = ra[i];
#pragma unroll
            for (int i = 0; i < 4; ++i) *(u32x4*)(Bs + (lrow + 64 * i) * LDT + lch * 8) = rb[i];
            __syncthreads();
            if (kt + 1 < nk) {
#pragma unroll
                for (int i = 0; i < 2; ++i) ra[i] = *(const u32x4*)(Ab + (size_t)(64 * i) * lda + (kt + 1) * BK);
#pragma unroll
                for (int i = 0; i < 4; ++i) rb[i] = *(const u32x4*)(Bb + (size_t)(64 * i) * ldb + (kt + 1) * BK);
            }
#pragma unroll
            for (int ks = 0; ks < 2; ++ks) {
                bf16x8 af[4], bfr[4];
#pragma unroll
                for (int m = 0; m < 4; ++m) af[m] = *(const bf16x8*)(As + (wr * 64 + m * 16 + fr) * LDT + ks * 32 + fq * 8);
#pragma unroll
                for (int n = 0; n < 4; ++n) bfr[n] = *(const bf16x8*)(Bs + (wc * 64 + n * 16 + fr) * LDT + ks * 32 + fq * 8);
#pragma unroll
                for (int m = 0; m < 4; ++m)
#pragma unroll
                    for (int n = 0; n < 4; ++n) acc[m][n] = __builtin_amdgcn_mfma_f32_16x16x32_bf16(bfr[n], af[m], acc[m][n], 0, 0, 0);
            }
        }
#pragma unroll
        for (int m = 0; m < 4; ++m)
#pragma unroll
            for (int n = 0; n < 4; ++n) epi(bz, tm * BM + wr * 64 + m * 16 + fr, tn * BN + wc * 64 + n * 16 + fq * 4, acc[m][n]);
    }
}

struct EpiPool {
    bf16_t* mix; const float* pb; const float* ps;
    __device__ __forceinline__ void operator()(int bz, int row, int col, f32x4 v) const {
        const int gc = bz * 256 + col;
        const f32x4 b = *(const f32x4*)(pb + gc), s = *(const f32x4*)(ps + gc);
        const f32x4 y = (v + b) * s;
        u32x2 o; o.x = pk_bf16(y[0], y[1]); o.y = pk_bf16(y[2], y[3]); *(u32x2*)(mix + (size_t)row * 1024 + gc) = o;
    }
};
namespace pg8 {
#define PG8_LAS __attribute__((address_space(3)))
constexpr int BM = 256, BK = 64, HALF = 128, HTB = HALF * BK * 2  , STAGE_BYTES = 8 * HTB, NXCD = 8, WGM = 8;
__host__ __device__ __forceinline__ int lds_byte(int r, int c) { const int st = (r >> 4) * 2 + (c >> 5), rr = r & 15, cc = c & 31, ob = rr * 64 + cc * 2; return st * 1024 + (ob ^ (((ob >> 9) & 1) << 5)); }
__host__ __device__ __forceinline__ void stage_rc(int b, int& R, int& C) { const int st = b / 1024, sb = b % 1024, swz = sb ^ (((sb >> 9) & 1) << 5); R = (st >> 1) * 16 + swz / 64; C = (st & 1) * 32 + (swz % 64) / 2; }
__host__ __device__ __forceinline__ int perm32(int rho) { const int n = rho >> 4, i = rho & 15; return 8 * (i >> 2) + 4 * n + (i & 3); }
struct Unit { int pm, pn; };
struct Gemm { const bf16_t* A; const bf16_t* Bt; int M, N, K; };
struct StaticOrder {
    int nM, nN, nwg, G, c;
    __host__ __device__ void init(int M, int N, int G_, int c_) { nM = M / BM; nN = N / BM; nwg = nM * nN; G = G_; c = c_; }
    __host__ __device__ bool next(int i, Unit& u) const {
        const long L = (long)i * G + c; if (L >= nwg) return false;
        int wgid = (int)L; { const int q = nwg / NXCD, r = nwg % NXCD, xcd = wgid % NXCD, off = wgid / NXCD; wgid = (xcd < r ? xcd * (q + 1) : r * (q + 1) + (xcd - r) * q) + off; }
        const int nig = WGM * nN, gid = wgid / nig, fm = gid * WGM, gsz = (nM - fm) < WGM ? (nM - fm) : WGM;
        u.pm = fm + ((wgid % nig) % gsz); u.pn = (wgid % nig) / gsz; return true;
    }
    __device__ __forceinline__ void a_ready(const Unit&) const {}
    __device__ __forceinline__ void done(const Unit&) const {}
};
template <class Epi, class Sched>
__device__ __forceinline__ void gemm_phase(PG8_LAS unsigned char* lds, const Gemm g, const Sched& S, const Epi& E) {
    const int tid = threadIdx.x, wid = __builtin_amdgcn_readfirstlane(tid >> 6), lane = tid & 63, wr = wid >> 2, wc = wid & 3, fr = lane & 15, fq = lane >> 4;
    const int K = g.K, nt = K / BK;
    unsigned voffA[2], voffB[2];
#pragma unroll
    for (int i = 0; i < 2; ++i) { int R, C; stage_rc(tid * 16 + i * 8192, R, C); const int Rb = Epi::PERM ? ((R & ~31) + perm32(R & 31)) : R;
        voffA[i] = (unsigned)(R * K + C) * 2u; voffB[i] = (unsigned)(Rb * K + C) * 2u; }
    const size_t kstep = (size_t)(BK * 2);
    const size_t hstep = (size_t)HALF * K * 2;
    const size_t tstep = 2 * hstep;
    const unsigned ldsw = (unsigned)wid * 1024u;
    const int aoff = lds_byte(wr * 64 + fr, fq * 8), boff = lds_byte(wc * 32 + fr, fq * 8);
#define PG8_SA(b, h) (((b) * 2 + (h)) * HTB)
#define PG8_SB(b, h) ((4 + (b) * 2 + (h)) * HTB)
#define PG8_STAGE(bufoff, gbase, voff) do { _Pragma("unroll") for (int _i = 0; _i < 2; ++_i) \
        __builtin_amdgcn_global_load_lds((const unsigned*)((const char*)(gbase) + (voff)[_i]), (PG8_LAS unsigned*)(lds + (bufoff) + ldsw + _i * 8192), 16, 0, 0); } while (0)
#define PG8_LDA(dst, b, h) do { _Pragma("unroll") for (int m = 0; m < 4; ++m) _Pragma("unroll") for (int k = 0; k < 2; ++k) dst[m][k] = *(const PG8_LAS bf16x8*)(lds + PG8_SA(b, h) + aoff + m * 2048 + k * 1024); } while (0)
#define PG8_LDB(dst, b, h) do { _Pragma("unroll") for (int n = 0; n < 2; ++n) _Pragma("unroll") for (int k = 0; k < 2; ++k) dst[n][k] = *(const PG8_LAS bf16x8*)(lds + PG8_SB(b, h) + boff + n * 2048 + k * 1024); } while (0)
#define PG8_MMA(ai, bj, At, Bt) do { __builtin_amdgcn_s_setprio(1); _Pragma("unroll") for (int m = 0; m < 4; ++m) _Pragma("unroll") for (int n = 0; n < 2; ++n) _Pragma("unroll") for (int k = 0; k < 2; ++k) \
        acc[ai][bj][m][n] = __builtin_amdgcn_mfma_f32_16x16x32_bf16(Bt[n][k], At[m][k], acc[ai][bj][m][n], 0, 0, 0); __builtin_amdgcn_s_setprio(0); } while (0)
#define PG8_WAIT_V(n) asm volatile("s_waitcnt vmcnt(" #n ")" ::: "memory")
#define PG8_WAIT_L(n) asm volatile("s_waitcnt lgkmcnt(" #n ")" ::: "memory")
#define PG8_BAR __builtin_amdgcn_s_barrier()
#define PG8_SCHED __builtin_amdgcn_sched_barrier(0)
    Unit cur, nxt; int ui = 0;
    if (!S.next(0, cur)) return;
    f32x4 acc[2][2][4][2];
#pragma unroll
    for (int a = 0; a < 2; ++a)
#pragma unroll
        for (int b = 0; b < 2; ++b)
#pragma unroll
            for (int m = 0; m < 4; ++m)
#pragma unroll
                for (int n = 0; n < 2; ++n) acc[a][b][m][n] = (f32x4){0.f, 0.f, 0.f, 0.f};
    bf16x8 At[4][2], B0[2][2], B1[2][2];
    const char* cA = (const char*)g.A + (size_t)cur.pm * tstep; const char* cB = (const char*)g.Bt + (size_t)cur.pn * tstep;
    S.a_ready(cur);
    PG8_STAGE(PG8_SB(0, 0), cB, voffB); PG8_STAGE(PG8_SA(0, 0), cA, voffA); PG8_STAGE(PG8_SB(0, 1), cB + hstep, voffB); PG8_STAGE(PG8_SA(0, 1), cA + hstep, voffA);
    if (wr == 1) PG8_BAR;
    PG8_WAIT_V(4); PG8_BAR;
    PG8_STAGE(PG8_SB(1, 0), cB + kstep, voffB); PG8_STAGE(PG8_SA(1, 0), cA + kstep, voffA); PG8_STAGE(PG8_SB(1, 1), cB + hstep + kstep, voffB);
    PG8_WAIT_V(6); PG8_BAR;
    for (;;) {
        const bool has_next = S.next(ui + 1, nxt);
        const char* nA = has_next ? (const char*)g.A + (size_t)nxt.pm * tstep : cA; const char* nB = has_next ? (const char*)g.Bt + (size_t)nxt.pn * tstep : cB;
        for (int t = 0; t < nt; t += 2) {
            const bool last = (t == nt - 2);
            const char* a1 = cA + (size_t)(t + 1) * kstep;
            const char* a2 = last ? nA : cA + (size_t)(t + 2) * kstep; const char* b2 = last ? nB : cB + (size_t)(t + 2) * kstep;
            const char* a3 = a2 + kstep; const char* b3 = b2 + kstep;
            if (last && has_next) S.a_ready(nxt);
            PG8_LDB(B0, 0, 0); PG8_SCHED; PG8_LDA(At, 0, 0); PG8_STAGE(PG8_SA(1, 1), a1 + hstep, voffA);
            PG8_WAIT_L(8); PG8_BAR; PG8_WAIT_L(0); PG8_MMA(0, 0, At, B0); PG8_BAR; PG8_SCHED;
            PG8_LDB(B1, 0, 1); PG8_STAGE(PG8_SB(0, 0), b2, voffB);
            PG8_BAR; PG8_WAIT_L(0); PG8_MMA(0, 1, At, B1); PG8_BAR;
            PG8_LDA(At, 0, 1); PG8_STAGE(PG8_SA(0, 0), a2, voffA);
            PG8_BAR; PG8_WAIT_L(0); PG8_MMA(1, 0, At, B0); PG8_BAR; PG8_SCHED;
            PG8_STAGE(PG8_SB(0, 1), b2 + hstep, voffB);
            PG8_WAIT_V(6); PG8_BAR; PG8_MMA(1, 1, At, B1); PG8_BAR;
            PG8_LDB(B0, 1, 0); PG8_SCHED; PG8_LDA(At, 1, 0); PG8_STAGE(PG8_SA(0, 1), a2 + hstep, voffA);
            PG8_WAIT_L(8); PG8_BAR; PG8_WAIT_L(0); PG8_MMA(0, 0, At, B0); PG8_BAR; PG8_SCHED;
            PG8_LDB(B1, 1, 1); PG8_STAGE(PG8_SB(1, 0), b3, voffB);
            PG8_BAR; PG8_WAIT_L(0); PG8_MMA(0, 1, At, B1); PG8_BAR;
            PG8_LDA(At, 1, 1); PG8_STAGE(PG8_SA(1, 0), a3, voffA);
            PG8_BAR; PG8_WAIT_L(0); PG8_MMA(1, 0, At, B0); PG8_BAR; PG8_SCHED;
            PG8_STAGE(PG8_SB(1, 1), b3 + hstep, voffB);
            PG8_WAIT_V(6); PG8_BAR; PG8_MMA(1, 1, At, B1); PG8_BAR;
        }
        E(acc, cur, wr, wc, fr, fq); S.done(cur);
        if (!has_next) break;
#pragma unroll
        for (int a = 0; a < 2; ++a)
#pragma unroll
            for (int b = 0; b < 2; ++b)
#pragma unroll
                for (int m = 0; m < 4; ++m)
#pragma unroll
                    for (int n = 0; n < 2; ++n) acc[a][b][m][n] = (f32x4){0.f, 0.f, 0.f, 0.f};
        cur = nxt; cA = nA; cB = nB; ++ui;
    }
    PG8_WAIT_V(0);
    if (wr == 0) PG8_BAR;
    PG8_BAR;
#undef PG8_SA
#undef PG8_SB
#undef PG8_STAGE
#undef PG8_LDA
#undef PG8_LDB
#undef PG8_MMA
#undef PG8_WAIT_V
#undef PG8_WAIT_L
#undef PG8_BAR
#undef PG8_SCHED
}
}

struct EpiG1 {
    static constexpr bool PERM = true, AFTER_DRAIN = false;
    bf16_t* hcat; bf16_t* vT;
    __device__ __forceinline__ void operator()(const f32x4 (&acc)[2][2][4][2], const pg8::Unit& u, int wr, int wc, int fr, int fq) const {
        const int row0 = u.pm * 256 + wr * 64 + fr, col0 = u.pn * 256 + wc * 32 + 8 * fq;
#pragma unroll
        for (int ai = 0; ai < 2; ++ai)
#pragma unroll
            for (int m = 0; m < 4; ++m) {
                const int row = row0 + ai * 128 + m * 16;
#pragma unroll
                for (int bj = 0; bj < 2; ++bj) {
                    const int col = col0 + bj * 128; const f32x4 v0 = acc[ai][bj][m][0], v1 = acc[ai][bj][m][1];
                    if (u.pn < 6) { u32x4 w; w.x = pk_bf16(v0[0], v0[1]); w.y = pk_bf16(v0[2], v0[3]); w.z = pk_bf16(v1[0], v1[1]); w.w = pk_bf16(v1[2], v1[3]); *(u32x4*)(hcat + (size_t)row * 1536 + col) = w; }
                    else {
                        const int c = col - 1536, hh = c >> 6, d = c & 63, b = row >> 11, s = row & 2047;
                        bf16_t* dst = vT + ((size_t)((b * 8 + hh) * 64 + d)) * 2048 + s;
#pragma unroll
                        for (int j = 0; j < 4; ++j) { dst[(size_t)j * 2048] = f2bf(v0[j]); dst[(size_t)(4 + j) * 2048] = f2bf(v1[j]); }
                    }
                }
            }
    }
};
struct EpiG2 {
    static constexpr bool PERM = true, AFTER_DRAIN = false;
    const bf16_t* h0b; bf16_t* y1;
    __device__ __forceinline__ void operator()(const f32x4 (&acc)[2][2][4][2], const pg8::Unit& u, int wr, int wc, int fr, int fq) const {
        const int row0 = u.pm * 256 + wr * 64 + fr, col0 = u.pn * 256 + wc * 32 + 8 * fq;
#pragma unroll
        for (int ai = 0; ai < 2; ++ai)
#pragma unroll
            for (int m = 0; m < 4; ++m) {
                const int row = row0 + ai * 128 + m * 16;
#pragma unroll
                for (int bj = 0; bj < 2; ++bj) {
                    const int col = col0 + bj * 128; const f32x4 v0 = acc[ai][bj][m][0], v1 = acc[ai][bj][m][1];
                    const u32x4 h = *(const u32x4*)(h0b + (size_t)row * 1024 + col);
                    u32x4 w;
                    w.x = pk_bf16(DN_ALPHA * bf_lo(h.x) + v0[0], DN_ALPHA * bf_hi(h.x) + v0[1]); w.y = pk_bf16(DN_ALPHA * bf_lo(h.y) + v0[2], DN_ALPHA * bf_hi(h.y) + v0[3]);
                    w.z = pk_bf16(DN_ALPHA * bf_lo(h.z) + v1[0], DN_ALPHA * bf_hi(h.z) + v1[1]); w.w = pk_bf16(DN_ALPHA * bf_lo(h.w) + v1[2], DN_ALPHA * bf_hi(h.w) + v1[3]);
                    *(u32x4*)(y1 + (size_t)row * 1024 + col) = w;
                }
            }
    }
};
struct EpiG3 {
    static constexpr bool PERM = true, AFTER_DRAIN = false;
    bf16_t* C; int ldc;
    __device__ __forceinline__ void operator()(const f32x4 (&acc)[2][2][4][2], const pg8::Unit& u, int wr, int wc, int fr, int fq) const {
        const int row0 = u.pm * 256 + wr * 64 + fr, col0 = u.pn * 256 + wc * 32 + 8 * fq;
#pragma unroll
        for (int ai = 0; ai < 2; ++ai)
#pragma unroll
            for (int m = 0; m < 4; ++m) {
                const int row = row0 + ai * 128 + m * 16;
#pragma unroll
                for (int bj = 0; bj < 2; ++bj) {
                    const int col = col0 + bj * 128; const f32x4 v0 = acc[ai][bj][m][0], v1 = acc[ai][bj][m][1];
                    u32x4 w; w.x = pk_bf16(v0[0], v0[1]); w.y = pk_bf16(v0[2], v0[3]); w.z = pk_bf16(v1[0], v1[1]); w.w = pk_bf16(v1[2], v1[3]);
                    *(u32x4*)(C + (size_t)row * ldc + col) = w;
                }
            }
    }
};

constexpr int ATT_HIST = 160, ATT_KEYS = 256 + ATT_HIST, ATT_KSTR = 72  , ATT_VSTR = ATT_KEYS + 8  ;
constexpr int ATT_K_BYTES = ATT_KEYS * ATT_KSTR * 2, ATT_LDS_BYTES = ATT_K_BYTES + 64 * ATT_VSTR * 2;
__device__ void phase_attn(const Params& p, unsigned char* smem) {
    const bf16_t* hcat = (const bf16_t*)(p.ws + WS_HCAT); const bf16_t* vT = (const bf16_t*)(p.ws + WS_VT); bf16_t* mix = (bf16_t*)(p.ws + WS_MIX);
    const int tid = threadIdx.x, lane = tid & 63, wid = tid >> 6, qi = lane & 31, hf = lane >> 5;
    bf16_t* Ks = (bf16_t*)smem; bf16_t* Vs = (bf16_t*)(smem + ATT_K_BYTES);
    for (int item = blockIdx.x; item < 512; item += gridDim.x) {
        const int c = item & 7, bh = item >> 3, b = bh >> 3, h = bh & 7;
        const int q0c = c * 256, lo = (q0c > ATT_HIST) ? q0c - ATT_HIST : 0, nkeys = q0c + 256 - lo;
        const size_t tb = (size_t)b * 2048;
        const int q0 = q0c + wid * 32, t = q0 + qi;
        bf16x8 qf[4];
        { const bf16_t* qrow = hcat + (tb + t) * 1536 + 512 + h * 64 + hf * 8;
#pragma unroll
          for (int s = 0; s < 4; ++s) qf[s] = *(const bf16x8*)(qrow + s * 16); }
        __syncthreads();
        {
            const int cpr = nkeys >> 3;
            u32x4 rk[7], rv[7];
#pragma unroll
            for (int j = 0; j < 7; ++j) { const int i = tid + NTHREADS * j; const int ic = (i < nkeys * 8) ? i : 0; const int key = ic >> 3, ch = ic & 7;
                rk[j] = *(const u32x4*)(hcat + (tb + lo + key) * 1536 + 1024 + h * 64 + ch * 8);
                const int d = ic / cpr, cv = ic - d * cpr;
                rv[j] = *(const u32x4*)(vT + (size_t)(bh * 64 + d) * 2048 + lo + cv * 8); }
#pragma unroll
            for (int j = 0; j < 7; ++j) { const int i = tid + NTHREADS * j; if (i < nkeys * 8) { const int key = i >> 3, ch = i & 7; *(u32x4*)(Ks + key * ATT_KSTR + ch * 8) = rk[j];
                const int d = i / cpr, cv = i - d * cpr; *(u32x4*)(Vs + d * ATT_VSTR + cv * 8) = rv[j]; } }
        }
        __syncthreads();
        f32x16 o0, o1;
#pragma unroll
        for (int r = 0; r < 16; ++r) { o0[r] = 0.f; o1[r] = 0.f; }
        float R = 0.f;
        const bf16_t* vbase = vT + (size_t)(bh * 64 + qi) * 2048 + 4 * hf;
        for (int k0 = q0; k0 >= 0; k0 -= 32) {
            bf16x8 kf[4], vf[2][2];
            if (k0 >= lo) {
                const int kl = k0 - lo;
                const bf16_t* kr = Ks + (kl + qi) * ATT_KSTR + hf * 8;
#pragma unroll
                for (int s = 0; s < 4; ++s) kf[s] = *(const bf16x8*)(kr + s * 16);
#pragma unroll
                for (int db = 0; db < 2; ++db)
#pragma unroll
                    for (int s = 0; s < 2; ++s) { const bf16_t* vr = Vs + (db * 32 + qi) * ATT_VSTR + kl + 16 * s + 4 * hf;
                        const u32x2 l = *(const u32x2*)vr, hh = *(const u32x2*)(vr + 8); u32x4 w; w.x = l.x; w.y = l.y; w.z = hh.x; w.w = hh.y; vf[db][s] = __builtin_bit_cast(bf16x8, w); }
            } else {
                const bf16_t* krow = hcat + (tb + k0 + qi) * 1536 + 1024 + h * 64 + hf * 8;
#pragma unroll
                for (int s = 0; s < 4; ++s) kf[s] = *(const bf16x8*)(krow + s * 16);
#pragma unroll
                for (int db = 0; db < 2; ++db)
#pragma unroll
                    for (int s = 0; s < 2; ++s) { const bf16_t* vr = vbase + (size_t)(db * 32) * 2048 + k0 + 16 * s;
                        const u32x2 l = *(const u32x2*)vr, hh = *(const u32x2*)(vr + 8); u32x4 w; w.x = l.x; w.y = l.y; w.z = hh.x; w.w = hh.y; vf[db][s] = __builtin_bit_cast(bf16x8, w); }
            }
            f32x16 sacc;
#pragma unroll
            for (int r = 0; r < 16; ++r) sacc[r] = 0.f;
#pragma unroll
            for (int s = 0; s < 4; ++s) sacc = __builtin_amdgcn_mfma_f32_32x32x16_bf16(kf[s], qf[s], sacc, 0, 0, 0);
            float zv[16], sfx[16], tot[4], ptot[4], after[4];
            const bool diag = (k0 == q0);
            unsigned vmask = 0xffffu;
            if (diag) { vmask = 0u;
#pragma unroll
                for (int r = 0; r < 16; ++r) vmask |= ((k0 + (r & 3) + 8 * (r >> 2) + 4 * hf) < t) ? (1u << r) : 0u; }
#pragma unroll
            for (int r = 0; r < 16; ++r) {
                const float z2 = sacc[r] * (0.125f * 1.44269504088896341f);
                const float sp2 = fmaxf(z2, 0.f) + __builtin_amdgcn_logf(1.f + __builtin_amdgcn_exp2f(-fabsf(z2)));
                zv[r] = z2; sfx[r] = (vmask >> r) & 1u ? -sp2 : 0.f;
            }
#pragma unroll
            for (int g = 0; g < 4; ++g) {
                sfx[4 * g + 2] += sfx[4 * g + 3]; sfx[4 * g + 1] += sfx[4 * g + 2]; sfx[4 * g] += sfx[4 * g + 1];
                tot[g] = sfx[4 * g];
            }
#pragma unroll
            for (int g = 0; g < 4; ++g) ptot[g] = __shfl_xor(tot[g], 32);
            float run = 0.f;
#pragma unroll
            for (int g = 3; g >= 0; --g) { after[g] = run + (hf == 0 ? ptot[g] : 0.f); run += tot[g] + ptot[g]; }
            unsigned apk[8];
#pragma unroll
            for (int r = 0; r < 16; r += 2) {
                const float e0 = __builtin_amdgcn_exp2f(zv[r] + sfx[r] + (after[r >> 2] + R)), e1 = __builtin_amdgcn_exp2f(zv[r + 1] + sfx[r + 1] + (after[(r + 1) >> 2] + R));
                apk[r >> 1] = pk_bf16((vmask >> r) & 1u ? e0 : 0.f, (vmask >> (r + 1)) & 1u ? e1 : 0.f);
            }
            R += run;
            u32x4 w0, w1; w0.x = apk[0]; w0.y = apk[1]; w0.z = apk[2]; w0.w = apk[3]; w1.x = apk[4]; w1.y = apk[5]; w1.z = apk[6]; w1.w = apk[7];
            const bf16x8 af0 = __builtin_bit_cast(bf16x8, w0), af1 = __builtin_bit_cast(bf16x8, w1);
            o0 = __builtin_amdgcn_mfma_f32_32x32x16_bf16(vf[0][0], af0, o0, 0, 0, 0);
            o0 = __builtin_amdgcn_mfma_f32_32x32x16_bf16(vf[0][1], af1, o0, 0, 0, 0);
            o1 = __builtin_amdgcn_mfma_f32_32x32x16_bf16(vf[1][0], af0, o1, 0, 0, 0);
            o1 = __builtin_amdgcn_mfma_f32_32x32x16_bf16(vf[1][1], af1, o1, 0, 0, 0);
            if (__all(R <= -127.0f)) break;
        }
        bf16_t* orow = mix + (tb + t) * 1024 + 512 + h * 64 + 4 * hf;
#pragma unroll
        for (int g = 0; g < 4; ++g) {
            u32x2 w; w.x = pk_bf16(o0[4 * g], o0[4 * g + 1]); w.y = pk_bf16(o0[4 * g + 2], o0[4 * g + 3]); *(u32x2*)(orow + 8 * g) = w;
            u32x2 w2; w2.x = pk_bf16(o1[4 * g], o1[4 * g + 1]); w2.y = pk_bf16(o1[4 * g + 2], o1[4 * g + 3]); *(u32x2*)(orow + 32 + 8 * g) = w2;
        }
    }
    __syncthreads();
}

template <int W> __device__ __forceinline__ void pool_item(const bf16_t* hcat, bf16_t* pooled, int t, int c8) {
    const int s = t & 2047, cnt = (s + 1 < W) ? (s + 1) : W;
    u32x4 v[W];
#pragma unroll
    for (int i = 0; i < W; ++i) { const int ti = t - ((i < cnt) ? i : (cnt - 1)); v[i] = *(const u32x4*)(hcat + (size_t)ti * 1536 + c8); }
    float acc[8];
#pragma unroll
    for (int j = 0; j < 8; ++j) acc[j] = 0.f;
#pragma unroll
    for (int i = 0; i < W; ++i) {
        const float wgt = (i < cnt) ? 1.f : 0.f;
        acc[0] += wgt * bf_lo(v[i].x); acc[1] += wgt * bf_hi(v[i].x); acc[2] += wgt * bf_lo(v[i].y); acc[3] += wgt * bf_hi(v[i].y);
        acc[4] += wgt * bf_lo(v[i].z); acc[5] += wgt * bf_hi(v[i].z); acc[6] += wgt * bf_lo(v[i].w); acc[7] += wgt * bf_hi(v[i].w);
    }
    const float inv = 1.0f / (float)cnt;
    u32x4 o; o.x = pk_bf16(acc[0] * inv - bf_lo(v[0].x), acc[1] * inv - bf_hi(v[0].x)); o.y = pk_bf16(acc[2] * inv - bf_lo(v[0].y), acc[3] * inv - bf_hi(v[0].y));
    o.z = pk_bf16(acc[4] * inv - bf_lo(v[0].z), acc[5] * inv - bf_hi(v[0].z)); o.w = pk_bf16(acc[6] * inv - bf_lo(v[0].w), acc[7] * inv - bf_hi(v[0].w));
    *(u32x4*)(pooled + (size_t)t * 512 + c8) = o;
}
__device__ void phase_poolprep(const Params& p) {
    const bf16_t* hcat = (const bf16_t*)(p.ws + WS_HCAT); bf16_t* pooled = (bf16_t*)(p.ws + WS_POOLED);
    const int lane = threadIdx.x & 63, wid = threadIdx.x >> 6;
    if (blockIdx.x >= 256) return;
    const int tm = blockIdx.x & 127, bz = blockIdx.x >> 7;
    for (int ii = wid; ii < 64; ii += NWAVES) {
        const int g = 2 * bz + (ii & 1), t = tm * 128 + (ii >> 1) * 4 + (lane >> 4), c8 = g * 128 + (lane & 15) * 8;
        if (g == 0) pool_item<2>(hcat, pooled, t, c8);
        else if (g == 1) pool_item<4>(hcat, pooled, t, c8);
        else if (g == 2) pool_item<8>(hcat, pooled, t, c8);
        else pool_item<16>(hcat, pooled, t, c8);
    }
}

__device__ void phase_ln1(const Params& p) {
    const int lane = threadIdx.x & 63, wid = threadIdx.x >> 6;
    const int gw = blockIdx.x * NWAVES + wid, nw = gridDim.x * NWAVES;
    const bf16_t* y1 = (const bf16_t*)(p.ws + WS_HCAT); bf16_t* x1b = (bf16_t*)(p.ws + WS_H0B);
    f32x4 gg[4], bb[4];
#pragma unroll
    for (int i = 0; i < 4; ++i) { gg[i] = *(const f32x4*)(p.ln1_g + 16 * lane + 4 * i); bb[i] = *(const f32x4*)(p.ln1_b + 16 * lane + 4 * i); }
    for (int r0 = gw; r0 < T_; r0 += 4 * nw) {
        u32x4 raw[4][2];
#pragma unroll
        for (int j = 0; j < 4; ++j) { const int r = min(r0 + j * nw, T_ - 1); raw[j][0] = *(const u32x4*)(y1 + (size_t)r * 1024 + 16 * lane); raw[j][1] = *(const u32x4*)(y1 + (size_t)r * 1024 + 16 * lane + 8); }
#pragma unroll
        for (int j = 0; j < 4; ++j) {
            const int r = r0 + j * nw; if (r >= T_) break;
            float v[16];
#pragma unroll
            for (int h = 0; h < 2; ++h) { v[8 * h] = bf_lo(raw[j][h].x); v[8 * h + 1] = bf_hi(raw[j][h].x); v[8 * h + 2] = bf_lo(raw[j][h].y); v[8 * h + 3] = bf_hi(raw[j][h].y);
                v[8 * h + 4] = bf_lo(raw[j][h].z); v[8 * h + 5] = bf_hi(raw[j][h].z); v[8 * h + 6] = bf_lo(raw[j][h].w); v[8 * h + 7] = bf_hi(raw[j][h].w); }
            float sm = 0.f;
#pragma unroll
            for (int i = 0; i < 16; ++i) sm += v[i];
            const float mean = wave_sum(sm) * (1.0f / 1024.0f);
            float q = 0.f;
#pragma unroll
            for (int i = 0; i < 16; ++i) { const float d = v[i] - mean; q += d * d; }
            const float rstd = rsqrtf(wave_sum(q) * (1.0f / 1024.0f) + LN_EPS);
            u32x4 o[2];
#pragma unroll
            for (int h = 0; h < 2; ++h) {
                float y[8];
#pragma unroll
                for (int i = 0; i < 8; ++i) y[i] = (v[8 * h + i] - mean) * rstd * gg[2 * h + (i >> 2)][i & 3] + bb[2 * h + (i >> 2)][i & 3];
                o[h].x = pk_bf16(y[0], y[1]); o[h].y = pk_bf16(y[2], y[3]); o[h].z = pk_bf16(y[4], y[5]); o[h].w = pk_bf16(y[6], y[7]);
            }
            *(u32x4*)(x1b + (size_t)r * 1024 + 16 * lane) = o[0]; *(u32x4*)(x1b + (size_t)r * 1024 + 16 * lane + 8) = o[1];
        }
    }
}

__device__ __forceinline__ unsigned ord_key(float f) { const unsigned u = __float_as_uint(f); return u ^ ((unsigned)((int)u >> 31) | 0x80000000u); }
__device__ __forceinline__ float ord_val(unsigned k) { const unsigned u = (k & 0x80000000u) ? (k ^ 0x80000000u) : ~k; return __uint_as_float(u); }

#define TK_CE(x, a, b) do { const unsigned hi_ = max((x)[a], (x)[b]), lo_ = min((x)[a], (x)[b]); (x)[a] = hi_; (x)[b] = lo_; } while (0)
template <int N> __device__ __forceinline__ void tk_merge_desc(unsigned (&x)[N]) {
#pragma unroll
    for (int k = N / 2; k >= 1; k >>= 1)
#pragma unroll
        for (int i = 0; i < N; ++i) if ((i & k) == 0) TK_CE(x, i, i | k);
}
template <int N> __device__ __forceinline__ void tk_sort_desc(unsigned (&x)[N]) {
#pragma unroll
    for (int sz = 2; sz <= N; sz <<= 1)
#pragma unroll
        for (int k = sz >> 1; k >= 1; k >>= 1)
#pragma unroll
            for (int i = 0; i < N; ++i) { const int l = i ^ k; if (l > i) { if ((i & sz) == 0) TK_CE(x, i, l); else TK_CE(x, l, i); } }
}
__device__ __forceinline__ void tk_top16(const unsigned (&a)[16], const unsigned (&b)[16], unsigned (&o)[16]) {
#pragma unroll
    for (int i = 0; i < 16; ++i) o[i] = max(a[i], b[15 - i]);
    tk_merge_desc<16>(o);
}

__device__ void phase_topk(const Params& p, unsigned char* smem) {
    const bf16_t* qp = (const bf16_t*)(p.ws + WS_HCAT); const bf16_t* subk = (const bf16_t*)(p.ws + WS_SUBK);
    int* idx = (int*)(p.ws + WS_MIX); float* gate = (float*)(p.ws + WS_MIX + 8 * MB); float* ginv = (float*)(p.ws + WS_MIX + 16 * MB);
    const int gw = blockIdx.x * NWAVES + ((int)threadIdx.x >> 6), nw = gridDim.x * NWAVES;
    constexpr int SK_STRIDE = 272, SK_BYTES = 256 * SK_STRIDE;
    {
        const int tid0 = threadIdx.x;
#pragma unroll
        for (int i = 0; i < 8; ++i) { const int c = tid0 + 512 * i, row = c >> 4, ch = c & 15;
            *(u32x4*)(smem + row * SK_STRIDE + ch * 16) = *(const u32x4*)(subk + (size_t)row * 128 + ch * 8); }
        __syncthreads();
    }
    for (int item = gw; item < 4096; item += nw) {
        int tid = threadIdx.x; asm volatile("" : "+v"(tid));
        const int lane = tid & 63, qi = lane & 31, hf = lane >> 5;
        const int R = item * 32 + qi;
        unsigned hf4 = (unsigned)hf << 2; asm volatile("" : "+v"(hf4));
        unsigned sel[2][16];
        bf16x8 qfa[2][8];
#pragma unroll
        for (int pp = 0; pp < 2; ++pp) { const bf16_t* qrow = qp + (size_t)R * 256 + pp * 128 + hf * 8;
#pragma unroll
            for (int s = 0; s < 8; ++s) qfa[pp][s] = *(const bf16x8*)(qrow + s * 16); }
#pragma unroll
        for (int pp = 0; pp < 2; ++pp) {
            bf16x8 qf[8];
#pragma unroll
            for (int s = 0; s < 8; ++s) qf[s] = qfa[pp][s];
            unsigned g[4][16];
#pragma unroll
            for (int nb = 0; nb < 4; ++nb) {
                f32x16 sc;
#pragma unroll
                for (int r = 0; r < 16; ++r) sc[r] = 0.f;
                const unsigned char* krow = smem + (pp * 128 + nb * 32 + qi) * SK_STRIDE + hf * 16;
#pragma unroll
                for (int s = 0; s < 8; ++s) { const bf16x8 kf = *(const bf16x8*)(krow + s * 32); sc = __builtin_amdgcn_mfma_f32_32x32x16_bf16(kf, qf[s], sc, 0, 0, 0); }
#pragma unroll
                for (int r = 0; r < 16; ++r) { const unsigned nbase = (unsigned)(nb * 32 + (r & 3) + 8 * (r >> 2)); g[nb][r] = ((ord_key(sc[r]) & 0xFFFFFF80u) | (127u ^ nbase)) ^ hf4; }
                tk_sort_desc<16>(g[nb]);
                __builtin_amdgcn_sched_barrier(0);
            }
            unsigned m01[16], m23[16], m[16], u[16];
            tk_top16(g[0], g[1], m01); tk_top16(g[2], g[3], m23); tk_top16(m01, m23, m);
#pragma unroll
            for (int i = 0; i < 16; ++i) u[i] = max(m[i], (unsigned)__shfl_xor((int)m[15 - i], 32));
            tk_merge_desc<16>(u);
#pragma unroll
            for (int i = 0; i < 16; ++i) sel[pp][i] = u[i];
            __builtin_amdgcn_sched_barrier(0);
        }
        float av[16], bv[16]; unsigned anb[4] = {0u, 0u, 0u, 0u}, bnb[4] = {0u, 0u, 0u, 0u};
#pragma unroll
        for (int i = 0; i < 16; ++i) { av[i] = ord_val(sel[0][i] & 0xFFFFFF80u); bv[i] = ord_val(sel[1][i] & 0xFFFFFF80u);
            anb[i >> 2] |= (127u - (sel[0][i] & 127u)) << (8 * (i & 3)); bnb[i >> 2] |= (127u - (sel[1][i] & 127u)) << (8 * (i & 3)); }
        unsigned char* tb = smem + SK_BYTES + (tid >> 6) * 2048 + lane * 32;
        *(u32x4*)tb = (u32x4){anb[0], anb[1], anb[2], anb[3]}; *(u32x4*)(tb + 16) = (u32x4){bnb[0], bnb[1], bnb[2], bnb[3]};
#define TK_CK(i, j) ((ord_key(av[i] + bv[j]) & 0xFFFFFF00u) | (unsigned)(255 - ((i) * 16 + (j))))
        unsigned cA[16], cB[16], cC[16], cD[16], m1[16], m2[16], best[16];
#pragma unroll
        for (int i = 0; i < 16; ++i) { cA[i] = TK_CK(i, 0); cB[i] = (i < 15) ? TK_CK(0, i + 1) : 0u; cD[i] = 0u; }
        cC[0] = TK_CK(1, 1); cC[1] = TK_CK(1, 2); cC[2] = TK_CK(1, 3); cC[3] = TK_CK(1, 4); cC[4] = TK_CK(1, 5); cC[5] = TK_CK(1, 6); cC[6] = TK_CK(1, 7);
        cC[7] = TK_CK(2, 1); cC[8] = TK_CK(2, 2); cC[9] = TK_CK(2, 3); cC[10] = TK_CK(2, 4);
        cC[11] = TK_CK(3, 1); cC[12] = TK_CK(3, 2); cC[13] = TK_CK(3, 3); cC[14] = TK_CK(4, 1); cC[15] = TK_CK(4, 2);
        cD[0] = TK_CK(5, 1); cD[1] = TK_CK(6, 1); cD[2] = TK_CK(7, 1);
#undef TK_CK
        tk_sort_desc<16>(cC);
        tk_top16(cA, cB, m1); tk_top16(cC, cD, m2); tk_top16(m1, m2, best);
        const float s0 = ord_val(best[0] & 0xFFFFFF00u);
        float ex[16], sum = 0.f; int eo[16];
#pragma unroll
        for (int k = 0; k < 16; ++k) {
            const unsigned pos = 255u - (best[k] & 255u);
            ex[k] = __expf(ord_val(best[k] & 0xFFFFFF00u) - s0); sum += ex[k];
            eo[k] = (int)tb[pos >> 4] * 128 + (int)tb[16 + (pos & 15)];
        }
        if (hf == 0) {
#pragma unroll
            for (int k = 0; k < 16; k += 4) {
                *(int4*)(idx + (size_t)R * 16 + k) = make_int4(eo[k], eo[k + 1], eo[k + 2], eo[k + 3]);
                *(f32x4*)(gate + (size_t)R * 16 + k) = (f32x4){ex[k], ex[k + 1], ex[k + 2], ex[k + 3]};
            }
            ginv[R] = 1.0f / sum;
        }
#pragma unroll 1
        for (int j = 0; j < 8; j += 4) convert_table_rows4(p, item * 8 + j, lane);
    }
}

typedef __bf16 bf16x2v __attribute__((ext_vector_type(2)));
constexpr int G2_XT_BYTES = 64 * 2048;
constexpr int G2_LIST_OFF = G2_XT_BYTES;
constexpr int G2_LDS_BYTES = G2_XT_BYTES + 8 * 1024 * 4;
constexpr int G2V_ACT_OFF = 96 * 1024;
constexpr int G2V_HILO = 0;
typedef int i32x2 __attribute__((ext_vector_type(2)));
constexpr size_t WS_ACT = WS_POOLED;
__device__ __forceinline__ unsigned g2_key(unsigned ent) { return ((ent >> 26) << 3) | ((ent >> 14) & 7u); }

__device__ __forceinline__ float gelu_as(float v) {
    const float av = fabsf(v), t = __builtin_amdgcn_rcpf(av * 0.2316418882f + 1.0f);
    float q = t * 0.5307027145f + (-0.7265760135f); q = q * t + 0.7107068705f; q = q * t + (-0.142248368f); q = q * t + 0.127414796f; q = q * t;
    const float e = __builtin_amdgcn_exp2f((v * v) * (-0.72134752044f));
    const float m = v * (q * e);
    return v < 0.f ? m : v - m;
}
__device__ __forceinline__ void g2u_issue(const unsigned char* u8, int entreg, int base, int lane, u32x4 (&ub)[8]) {
#pragma unroll
    for (int j = 0; j < 8; ++j) { const unsigned roff = (unsigned)__builtin_amdgcn_readlane(entreg, base + j) >> 7 & 0xfffffc00u;
        ub[j] = *(const u32x4*)(u8 + roff + 16 * lane); }
}
__device__ __forceinline__ float g2u_compute(const unsigned char* xw, int entreg, float sureg, float gsreg, int base, int lane, const u32x4 (&ub)[8]) {
    float s[8];
#pragma unroll
    for (int j = 0; j < 8; ++j) {
        const int slot = (__builtin_amdgcn_readlane(entreg, base + j) >> 14) & 7;
        const u32x4 x = *(const u32x4*)(xw + slot * 1024 + 16 * lane);
        int d = 0;
#pragma unroll
        for (int w = 0; w < 4; ++w) d = __builtin_amdgcn_sdot4((int)ub[j][w], (int)x[w], d, false);
        s[j] = (float)d;
    }
    const float q0 = swap16_add(swap32_add(s[0], s[4]), swap32_add(s[2], s[6]));
    const float q1 = swap16_add(swap32_add(s[1], s[5]), swap32_add(s[3], s[7]));
    const bool b3 = (lane & 8) != 0;
    const float keep = b3 ? q1 : q0, send = b3 ? q0 : q1;
    float r = keep + dpp_f<0x128>(send);
    r += dpp_f<0xB1>(r); r += dpp_f<0x4E>(r); r += dpp_f<0x141>(r);
    const float su = __shfl(sureg, base + (lane >> 3)), gs = __shfl(gsreg, base + (lane >> 3));
    const float hid = r * su;
    return gelu_as(hid) * gs;
}

__device__ __forceinline__ void g2v_issue(const unsigned char* vlane, int e, u32x4 (&vb)[8]) {
    const unsigned char* r = vlane + (size_t)e * 1024;
#pragma unroll
    for (int c = 0; c < 8; ++c) vb[c] = *(const u32x4*)(r + c * 128);
}
__device__ __forceinline__ void g2v_compute(f32x2 (&acc)[8][8], float a, const u32x4 (&vb)[8]) {
    const f32x2 a2 = {a, a};
#pragma unroll
    for (int c = 0; c < 8; ++c)
#pragma unroll
        for (int w = 0; w < 4; ++w) {
            const f32x2 lo = __builtin_amdgcn_cvt_pk_f32_fp8((int)vb[c][w], false), hi = __builtin_amdgcn_cvt_pk_f32_fp8((int)vb[c][w], true);
            asm("v_pk_fma_f32 %0, %1, %2, %0" : "+v"(acc[c][2 * w]) : "v"(a2), "v"(lo));
            asm("v_pk_fma_f32 %0, %1, %2, %0" : "+v"(acc[c][2 * w + 1]) : "v"(a2), "v"(hi));
        }
}

__device__ void phase_gather2(const Params& p, unsigned char* smem) {
    const unsigned char* u8 = p.ws + WS_U8; const unsigned char* v8 = p.ws + WS_V8;
    const float* su = (const float*)(p.ws + WS_SU); const float* sv = (const float*)(p.ws + WS_SV);
    const int* idx = (const int*)(p.ws + WS_MIX); const float* gate = (const float*)(p.ws + WS_MIX + 8 * MB); const float* ginv = (const float*)(p.ws + WS_MIX + 16 * MB);
    const bf16_t* x1b = (const bf16_t*)(p.ws + WS_H0B);
    const int wid = __builtin_amdgcn_readfirstlane((int)threadIdx.x >> 6);
    unsigned* lst = (unsigned*)(smem + G2_LIST_OFF) + wid * 1024;
    unsigned* cnt = (unsigned*)smem + wid * 1024;
    unsigned* bas = cnt + 256;
    {
        const int tile = blockIdx.x; if (tile >= T_ / 64) return;
        const int tid = threadIdx.x, lane = tid & 63;
        const int tok0 = tile * 64, tw = tok0 + wid * 8;
        float* isclg = (float*)(p.ws + WS_ACT) + (size_t)tile * 64;
        float* actl = (float*)(smem + G2V_ACT_OFF) + wid * 1024;
        __syncthreads();
        *(u32x4*)(cnt + 4 * lane) = (u32x4){0u, 0u, 0u, 0u};
        __syncthreads();
        {
            unsigned ent[16], rnk[16];
#pragma unroll
            for (int i = 0; i < 16; ++i) {
                const int slot = i >> 1, k = (i & 1) * 64 + lane;
                const unsigned e = (unsigned)idx[(size_t)(tw + slot) * 128 + k];
                ent[i] = (e << 17) | ((unsigned)slot << 14) | ((unsigned)k << 7);
                rnk[i] = atomicAdd(&cnt[g2_key(ent[i])], 1u);
            }
            __syncthreads();
            {
                const u32x4 c = *(const u32x4*)(cnt + 4 * lane);
                const unsigned tot = c.x + c.y + c.z + c.w; unsigned incl = tot;
#pragma unroll
                for (int o = 1; o < 64; o <<= 1) { const unsigned v = (unsigned)__shfl_up((int)incl, o); if (lane >= o) incl += v; }
                const unsigned ex = incl - tot;
                u32x4 b; b.x = ex; b.y = ex + c.x; b.z = ex + c.x + c.y; b.w = ex + c.x + c.y + c.z;
                *(u32x4*)(bas + 4 * lane) = b;
            }
            __syncthreads();
#pragma unroll
            for (int i = 0; i < 16; ++i) {
                const unsigned key = g2_key(ent[i]);
                lst[bas[key] + rnk[i]] = ent[i];
            }
        }
        __syncthreads();
        unsigned char* xwp = smem + wid * 8 * 1024;
        float* sxw = (float*)(smem + 64 * 1024) + wid * 8;
#pragma unroll 1
        for (int sl = 0; sl < 8; ++sl) {
            const bf16_t* xr = x1b + (size_t)(tw + sl) * 1024 + 16 * lane;
            const u32x4 a = *(const u32x4*)xr, b = *(const u32x4*)(xr + 8);
            const float v[16] = {bf_lo(a.x), bf_hi(a.x), bf_lo(a.y), bf_hi(a.y), bf_lo(a.z), bf_hi(a.z), bf_lo(a.w), bf_hi(a.w), bf_lo(b.x), bf_hi(b.x), bf_lo(b.y), bf_hi(b.y), bf_lo(b.z), bf_hi(b.z), bf_lo(b.w), bf_hi(b.w)};
            float amax = 0.f;
#pragma unroll
            for (int i = 0; i < 16; ++i) amax = fmaxf(amax, fabsf(v[i]));
#pragma unroll
            for (int o = 32; o > 0; o >>= 1) amax = fmaxf(amax, __shfl_xor(amax, o));
            const float sc = amax > 0.f ? 127.0f / amax : 1.0f;
            u32x4 w;
#pragma unroll
            for (int i = 0; i < 4; ++i) w[i] = q8x4(v[4 * i] * sc, v[4 * i + 1] * sc, v[4 * i + 2] * sc, v[4 * i + 3] * sc);
            *(u32x4*)(xwp + sl * 1024 + 16 * lane) = w;
            if (lane == 0) sxw[sl] = amax > 0.f ? amax * (1.0f / 127.0f) : 1.0f;
        }
        {
            const unsigned char* xw = xwp;
            int entA = (int)lst[lane];
            float suA, gsA;
            { const int e = entA >> 17, slot = (entA >> 14) & 7, k = (entA >> 7) & 127; const size_t tk = (size_t)(tw + slot);
              suA = su[e] * sxw[slot]; gsA = gate[tk * 128 + k] * ginv[tk * 8 + (k >> 4)] * sv[e]; }
            u32x4 ub0[8], ub1[8], ub2[8], ub3[8];
            g2u_issue(u8, entA, 0, lane, ub0); g2u_issue(u8, entA, 8, lane, ub1); g2u_issue(u8, entA, 16, lane, ub2);
#pragma unroll 1
            for (int chunk = 0; chunk < 16; ++chunk) {
                const bool more = chunk < 15;
                const int entN = (int)lst[(more ? chunk + 1 : chunk) * 64 + lane];
                float suN, gsN;
                { const int e = entN >> 17, slot = (entN >> 14) & 7, k = (entN >> 7) & 127; const size_t tk = (size_t)(tw + slot);
                  suN = su[e] * sxw[slot]; gsN = gate[tk * 128 + k] * ginv[tk * 8 + (k >> 4)] * sv[e]; }
                float actchunk = 0.f;
#define G2U_STEP(J, BC, BN) do { if (J + 3 < 8) g2u_issue(u8, entA, (J + 3) * 8, lane, BN); else if (more) g2u_issue(u8, entN, (J + 3 - 8) * 8, lane, BN); \
                    const float a_ = g2u_compute(xw, entA, suA, gsA, J * 8, lane, BC); const float v_ = __shfl(a_, (lane & 7) * 8); actchunk = ((lane >> 3) == J) ? v_ : actchunk; } while (0)
                G2U_STEP(0, ub0, ub3); G2U_STEP(1, ub1, ub0); G2U_STEP(2, ub2, ub1); G2U_STEP(3, ub3, ub2);
                G2U_STEP(4, ub0, ub3); G2U_STEP(5, ub1, ub0); G2U_STEP(6, ub2, ub1); G2U_STEP(7, ub3, ub2);
#undef G2U_STEP
                actl[chunk * 64 + lane] = actchunk;
                entA = entN; suA = suN; gsA = gsN;
            }
        }
        {
            float am[8];
#pragma unroll
            for (int sI = 0; sI < 8; ++sI) am[sI] = 0.f;
#pragma unroll 1
            for (int ch = 0; ch < 16; ++ch) {
                const unsigned e = lst[ch * 64 + lane]; const float a = fabsf(actl[ch * 64 + lane]); const unsigned sl = (e >> 14) & 7u;
#pragma unroll
                for (int sI = 0; sI < 8; ++sI) am[sI] = fmaxf(am[sI], sl == (unsigned)sI ? a : 0.f);
            }
#pragma unroll
            for (int sI = 0; sI < 8; ++sI) {
#pragma unroll
                for (int o = 32; o > 0; o >>= 1) am[sI] = fmaxf(am[sI], __shfl_xor(am[sI], o));
            }
            float sc[8];
#pragma unroll
            for (int sI = 0; sI < 8; ++sI) sc[sI] = am[sI] > 0.f ? 240.0f / am[sI] : 1.0f;
#pragma unroll 1
            for (int ch = 0; ch < 16; ++ch) {
                const unsigned e = lst[ch * 64 + lane]; const unsigned sl = (e >> 14) & 7u;
                float f = sc[0];
#pragma unroll
                for (int sI = 1; sI < 8; ++sI) f = sl == (unsigned)sI ? sc[sI] : f;
                actl[ch * 64 + lane] *= f;
            }
            float myi = 1.0f;
#pragma unroll
            for (int sI = 0; sI < 8; ++sI) myi = (lane == sI) ? (am[sI] > 0.f ? am[sI] * (1.0f / 240.0f) : 1.0f) : myi;
            if (lane < 8) __hip_atomic_store(isclg + wid * 8 + lane, myi, __ATOMIC_RELAXED, __HIP_MEMORY_SCOPE_AGENT);
        }
        asm volatile("s_waitcnt vmcnt(0) lgkmcnt(0)" ::: "memory");
        __syncthreads();
        f32x4 acc[32];
#pragma unroll
        for (int i = 0; i < 32; ++i) acc[i] = (f32x4){0.f, 0.f, 0.f, 0.f};
        const int g = wid >> 1, h = wid & 1;
        unsigned char* stage = smem + wid * 8192;
        {
            const int m = lane & 15, kq = lane >> 4, sel = kq >> 1;
            const unsigned myslot = ((m >> 3) == sel) ? (unsigned)(m & 7) : 8u;
            const unsigned lbase = (unsigned)((2 * g + sel) * 4096 + (kq & 1) * 32);
            const int rr = lane >> 3, pj = lane & 7;
            const unsigned dcol = (unsigned)(512 * h + 16 * pj);
            const unsigned eoff0 = (unsigned)((2 * g) * 4096 + rr * 4), eoff1 = eoff0 + 32u, eoff2 = eoff0 + 4096u, eoff3 = eoff0 + 4096u + 32u;
            const unsigned char* lsts = smem + G2_LIST_OFF; const unsigned char* acts = smem + G2V_ACT_OFF;
            const unsigned wrE = (unsigned)(pj * 128 + ((rr + pj) & 7) * 16), wrO = (unsigned)((pj ^ 1) * 128 + ((rr + pj) & 7) * 16);
            unsigned rotv[8];
            { const unsigned sb = (unsigned)(size_t)((PG8_LAS unsigned char*)smem) + (unsigned)(wid * 8192 + kq * 1024 + 8 * (m & 1));
#pragma unroll
              for (int jj = 0; jj < 8; ++jj) rotv[jj] = sb + (unsigned)(((jj ^ (kq & 1)) * 128) + ((((m >> 1) + jj) & 7) << 4)); }
            unsigned roC[4], roN[4];
            u32x4 vb[4][4];
#define G2V_ENT(off) (*(const unsigned*)(lsts + (off)))
#define G2V_ROFF(RO, J) do { const unsigned jo_ = 64u * (unsigned)(J); \
                RO[0] = ((G2V_ENT(eoff0 + jo_) >> 7) & 0xfffffc00u) + dcol; RO[1] = ((G2V_ENT(eoff1 + jo_) >> 7) & 0xfffffc00u) + dcol; \
                RO[2] = ((G2V_ENT(eoff2 + jo_) >> 7) & 0xfffffc00u) + dcol; RO[3] = ((G2V_ENT(eoff3 + jo_) >> 7) & 0xfffffc00u) + dcol; } while (0)
#define G2V_LOAD(RO, CQ) do { _Pragma("unroll") for (int kk_ = 0; kk_ < 4; ++kk_) vb[CQ][kk_] = *(const u32x4*)(v8 + RO[kk_] + 128u * (CQ)); } while (0)
#define G2V_TR8(OFS) asm volatile("ds_read_b64_tr_b8 %0, %8 offset:" OFS "\n\tds_read_b64_tr_b8 %1, %9 offset:" OFS "\n\tds_read_b64_tr_b8 %2, %10 offset:" OFS "\n\tds_read_b64_tr_b8 %3, %11 offset:" OFS "\n\t" \
                             "ds_read_b64_tr_b8 %4, %12 offset:" OFS "\n\tds_read_b64_tr_b8 %5, %13 offset:" OFS "\n\tds_read_b64_tr_b8 %6, %14 offset:" OFS "\n\tds_read_b64_tr_b8 %7, %15 offset:" OFS "\n\t" \
                             "s_waitcnt lgkmcnt(0)" \
                             : "=&v"(b_[0]), "=&v"(b_[1]), "=&v"(b_[2]), "=&v"(b_[3]), "=&v"(b_[4]), "=&v"(b_[5]), "=&v"(b_[6]), "=&v"(b_[7]) \
                             : "v"(rotv[0]), "v"(rotv[1]), "v"(rotv[2]), "v"(rotv[3]), "v"(rotv[4]), "v"(rotv[5]), "v"(rotv[6]), "v"(rotv[7]) : "memory")
#define G2V_STEP(CQ) do { unsigned char* sb_ = stage + ((CQ) & 1) * 4096; \
                _Pragma("unroll") for (int kk_ = 0; kk_ < 4; ++kk_) *(u32x4*)(sb_ + kk_ * 1024 + ((kk_ & 1) ? wrO : wrE)) = vb[CQ][kk_]; \
                G2V_LOAD(roN, CQ); \
                i32x2 b_[8]; \
                if ((CQ) & 1) G2V_TR8("4096"); else G2V_TR8("0"); \
                _Pragma("unroll") for (int jj_ = 0; jj_ < 8; ++jj_) { const long bb_ = __builtin_bit_cast(long, b_[jj_]); \
                    acc[8 * (CQ) + jj_] = __builtin_amdgcn_mfma_f32_16x16x32_fp8_fp8(Ahi, bb_, acc[8 * (CQ) + jj_], 0, 0, 0); \
                    if (G2V_HILO) acc[8 * (CQ) + jj_] = __builtin_amdgcn_mfma_f32_16x16x32_fp8_fp8(Alo, bb_, acc[8 * (CQ) + jj_], 0, 0, 0); } } while (0)
            G2V_ROFF(roC, 0);
            G2V_LOAD(roC, 0); __builtin_amdgcn_sched_barrier(0); G2V_LOAD(roC, 1); __builtin_amdgcn_sched_barrier(0); G2V_LOAD(roC, 2); __builtin_amdgcn_sched_barrier(0); G2V_LOAD(roC, 3); __builtin_amdgcn_sched_barrier(0);
#pragma unroll 1
            for (int j = 0; j < 64; ++j) {
                G2V_ROFF(roN, j < 63 ? j + 1 : j);
                long Ahi, Alo;
                {
                    const unsigned o_ = lbase + 64u * (unsigned)j;
                    const u32x4 e0 = *(const u32x4*)(lsts + o_), e1 = *(const u32x4*)(lsts + o_ + 16);
                    const f32x4 a0 = *(const f32x4*)(acts + o_), a1 = *(const f32x4*)(acts + o_ + 16);
                    float v[8];
#pragma unroll
                    for (int t = 0; t < 4; ++t) { v[t] = (((e0[t] >> 14) & 7u) == myslot) ? a0[t] : 0.f; v[4 + t] = (((e1[t] >> 14) & 7u) == myslot) ? a1[t] : 0.f; }
                    int h0 = __builtin_amdgcn_cvt_pk_fp8_f32(v[0], v[1], 0, false); h0 = __builtin_amdgcn_cvt_pk_fp8_f32(v[2], v[3], h0, true);
                    int h1 = __builtin_amdgcn_cvt_pk_fp8_f32(v[4], v[5], 0, false); h1 = __builtin_amdgcn_cvt_pk_fp8_f32(v[6], v[7], h1, true);
                    Ahi = (long)(((unsigned long)(unsigned)h1 << 32) | (unsigned long)(unsigned)h0);
                    const f32x2 d0 = __builtin_amdgcn_cvt_pk_f32_fp8(h0, false), d1 = __builtin_amdgcn_cvt_pk_f32_fp8(h0, true), d2 = __builtin_amdgcn_cvt_pk_f32_fp8(h1, false), d3 = __builtin_amdgcn_cvt_pk_f32_fp8(h1, true);
                    int l0 = __builtin_amdgcn_cvt_pk_fp8_f32(v[0] - d0.x, v[1] - d0.y, 0, false); l0 = __builtin_amdgcn_cvt_pk_fp8_f32(v[2] - d1.x, v[3] - d1.y, l0, true);
                    int l1 = __builtin_amdgcn_cvt_pk_fp8_f32(v[4] - d2.x, v[5] - d2.y, 0, false); l1 = __builtin_amdgcn_cvt_pk_fp8_f32(v[6] - d3.x, v[7] - d3.y, l1, true);
                    Alo = (long)(((unsigned long)(unsigned)l1 << 32) | (unsigned long)(unsigned)l0);
                }
                G2V_STEP(0); G2V_STEP(1); G2V_STEP(2); G2V_STEP(3);
#pragma unroll
                for (int kk = 0; kk < 4; ++kk) roC[kk] = roN[kk];
            }
#undef G2V_ENT
#undef G2V_ROFF
#undef G2V_LOAD
#undef G2V_STEP
#undef G2V_TR8
        }
        {
            const int q = lane >> 4, n = lane & 15;
            float isc[4];
#pragma unroll
            for (int r = 0; r < 4; ++r) isc[r] = __hip_atomic_load(isclg + (2 * g + (q >> 1)) * 8 + 4 * (q & 1) + r, __ATOMIC_RELAXED, __HIP_MEMORY_SCOPE_AGENT);
            f32x4 y[4][8];
#pragma unroll
            for (int r = 0; r < 4; ++r) {
                u32x2 xv[8];
#pragma unroll
                for (int i = 0; i < 8; ++i) xv[i] = *(const u32x2*)(x1b + (size_t)(tok0 + 16 * g + 4 * (i >> 1) + r) * 1024 + 512 * h + 256 * (i & 1) + 4 * lane);
                float* sw = (float*)stage + q * 512 + n;
#pragma unroll
                for (int nt = 0; nt < 32; ++nt) sw[16 * nt] = acc[nt][r] * isc[r];
#pragma unroll
                for (int i = 0; i < 8; ++i) {
                    const f32x4 f = *(const f32x4*)((const float*)stage + i * 256 + 4 * lane);
                    y[r][i][0] = f[0] + DN_ALPHA * bf_lo(xv[i].x); y[r][i][1] = f[1] + DN_ALPHA * bf_hi(xv[i].x);
                    y[r][i][2] = f[2] + DN_ALPHA * bf_lo(xv[i].y); y[r][i][3] = f[3] + DN_ALPHA * bf_hi(xv[i].y);
                }
                __builtin_amdgcn_sched_barrier(0);
            }
            float* red = (float*)(smem + G2V_ACT_OFF) + wid * 1024; const float* redp = (const float*)(smem + G2V_ACT_OFF) + (wid ^ 1) * 1024;
            float sm[4][4];
#pragma unroll
            for (int r = 0; r < 4; ++r)
#pragma unroll
                for (int t = 0; t < 4; ++t) { const f32x4 a = y[r][2 * t], b = y[r][2 * t + 1]; sm[r][t] = wave_sum(((a[0] + a[1]) + (a[2] + a[3])) + ((b[0] + b[1]) + (b[2] + b[3]))); }
            __syncthreads();
            if (lane == 0) {
#pragma unroll
                for (int r = 0; r < 4; ++r)
#pragma unroll
                    for (int t = 0; t < 4; ++t) red[4 * t + r] = sm[r][t];
            }
            __syncthreads();
            float mean[4][4], q2[4][4];
#pragma unroll
            for (int r = 0; r < 4; ++r)
#pragma unroll
                for (int t = 0; t < 4; ++t) {
                    mean[r][t] = (sm[r][t] + redp[4 * t + r]) * (1.0f / 1024.0f);
                    float qq = 0.f;
#pragma unroll
                    for (int u = 0; u < 2; ++u)
#pragma unroll
                        for (int e = 0; e < 4; ++e) { y[r][2 * t + u][e] -= mean[r][t]; qq += y[r][2 * t + u][e] * y[r][2 * t + u][e]; }
                    q2[r][t] = wave_sum(qq);
                }
            if (lane == 0) {
#pragma unroll
                for (int r = 0; r < 4; ++r)
#pragma unroll
                    for (int t = 0; t < 4; ++t) red[16 + 4 * t + r] = q2[r][t];
            }
            __syncthreads();
            f32x4 gg[2], bb[2];
#pragma unroll
            for (int u = 0; u < 2; ++u) { gg[u] = *(const f32x4*)(p.ln2_g + 512 * h + 256 * u + 4 * lane); bb[u] = *(const f32x4*)(p.ln2_b + 512 * h + 256 * u + 4 * lane); }
#pragma unroll
            for (int r = 0; r < 4; ++r)
#pragma unroll
                for (int t = 0; t < 4; ++t) {
                    const float rstd = rsqrtf((q2[r][t] + redp[16 + 4 * t + r]) * (1.0f / 1024.0f) + LN_EPS);
#pragma unroll
                    for (int u = 0; u < 2; ++u)
                        *(f32x4*)(p.out + (size_t)(tok0 + 16 * g + 4 * t + r) * 1024 + 512 * h + 256 * u + 4 * lane) = y[r][2 * t + u] * rstd * gg[u] + bb[u];
                }
        }
    }
}

#define XB_TMO      128
#define XB_XCNT(j)  (256  + 64 * (j))
#define XB_XSUB(j)  (1280 + 64 * (j))
#define XB_XGEN(j)  (2304 + 64 * (j))
#define XB_TOP      3328
#define XB_TOPGEN   3392
#define XCD_BAR_WORDS 3456
#define XB_SPIN_CAP (1u << 18)
#define LAS __attribute__((address_space(3)))
__device__ __forceinline__ unsigned xb_ld(unsigned* p)              { return __hip_atomic_load(p, __ATOMIC_RELAXED, __HIP_MEMORY_SCOPE_AGENT); }
__device__ __forceinline__ unsigned xb_add(unsigned* p, unsigned v) { return __hip_atomic_fetch_add(p, v, __ATOMIC_RELAXED, __HIP_MEMORY_SCOPE_AGENT); }
__device__ __forceinline__ unsigned xb_xcc_id() { return (unsigned)__builtin_amdgcn_s_getreg((3 << 11) | 20) & 0xFu; }
#define XB_SPIN(cond, bar) do { unsigned _sp = 0; while (cond) { __builtin_amdgcn_s_sleep(1); \
    if ((++_sp & 255u) == 0u) { if (xb_ld(&(bar)[XB_TMO])) break; if (_sp > XB_SPIN_CAP) { atomicAdd(&(bar)[XB_TMO], 1u); break; } } } } while (0)
struct XcdBarrier { unsigned* bar; unsigned x; volatile LAS unsigned* st; };
__device__ __forceinline__ XcdBarrier xcd_barrier_post(unsigned* bar, volatile LAS unsigned* st) {
    XcdBarrier b; b.bar = bar; b.x = xb_xcc_id(); b.st = st;
    if (threadIdx.x == 0) (void)xb_add(&bar[XB_XCNT(b.x)], 1u);
    return b;
}
__device__ __forceinline__ void xcd_barrier_complete(unsigned* bar, unsigned x, unsigned& nloc, unsigned& nx) {
    const unsigned G = gridDim.x * gridDim.y * gridDim.z;
    unsigned sum, cnt, mine, sp = 0u;
    for (;;) {
        sum = 0u; cnt = 0u; mine = 0u;
#pragma unroll
        for (unsigned j = 0; j < 16; ++j) { const unsigned c = xb_ld(&bar[XB_XCNT(j)]); sum += c; cnt += (c > 0u) ? 1u : 0u; mine = (j == x) ? c : mine; }
        if (sum == G) break;
        __builtin_amdgcn_s_sleep(1);
        if ((++sp & 255u) == 0u) { if (xb_ld(&bar[XB_TMO])) break; if (sp > XB_SPIN_CAP) { atomicAdd(&bar[XB_TMO], 1u); break; } }
    }
    nloc = mine > 0u ? mine : 1u; nx = cnt > 0u ? cnt : 1u;
}
__device__ __forceinline__ void xcd_barrier(const XcdBarrier& b) {
    asm volatile("s_waitcnt vmcnt(0)" ::: "memory");
    __syncthreads();
    if (threadIdx.x == 0) {
        unsigned* bar = b.bar;
        __builtin_amdgcn_s_waitcnt(0);
        unsigned nloc = b.st[0], nx = b.st[1];
        if (nloc == 0u) { xcd_barrier_complete(bar, b.x, nloc, nx); b.st[0] = nloc; b.st[1] = nx; }
        const unsigned old = xb_add(&bar[XB_XSUB(b.x)], 1u);
        const unsigned gen = old / nloc;
        if (old + 1u == (gen + 1u) * nloc) {
            __builtin_amdgcn_fence(__ATOMIC_RELEASE, "agent");
            asm volatile("s_waitcnt vmcnt(0)" ::: "memory");
            const unsigned og = xb_add(&bar[XB_TOP], 1u);
            const unsigned tg = og / nx;
            if (og + 1u == (tg + 1u) * nx) xb_add(&bar[XB_TOPGEN], 1u);
            else XB_SPIN(xb_ld(&bar[XB_TOPGEN]) == tg, bar);
            __builtin_amdgcn_fence(__ATOMIC_ACQUIRE, "agent");
            xb_add(&bar[XB_XGEN(b.x)], 1u);
            asm volatile("s_waitcnt vmcnt(0)" ::: "memory");
        } else {
            XB_SPIN(xb_ld(&bar[XB_XGEN(b.x)]) == gen, bar);
            __builtin_amdgcn_fence(__ATOMIC_ACQUIRE, "agent");
            asm volatile("s_waitcnt vmcnt(0)" ::: "memory");
        }
    }
    __syncthreads();
}

__device__ __forceinline__ void run_phase(int ph, const Params& p, unsigned char* smem, bool dummy = false, const XcdBarrier* rb = nullptr) {
    if (ph == 0) phase_prep(p, smem);
    if (ph == 1) { pg8::Gemm g{(const bf16_t*)(p.ws + WS_H0B), (const bf16_t*)(p.ws + WS_WIN), T_, 2048, 1024}; pg8::StaticOrder S; S.init(T_, 2048, gridDim.x, blockIdx.x);
        EpiG1 e{(bf16_t*)(p.ws + WS_HCAT), (bf16_t*)(p.ws + WS_VT)}; pg8::gemm_phase((PG8_LAS unsigned char*)smem, g, S, e); }
    if (ph == 2) {
        phase_attn(p, smem); phase_poolprep(p);
        asm volatile("s_waitcnt vmcnt(0)" ::: "memory"); __syncthreads();
        EpiPool e{(bf16_t*)(p.ws + WS_MIX), p.pool_b, p.pool_scale};
        gemm_phase((const bf16_t*)(p.ws + WS_POOLED), 512, 256, (const bf16_t*)(p.ws + WS_POOLW), 256, 65536, T_, 256, 256, 2, e, smem);
    }
    if (ph == 4) { pg8::Gemm g{(const bf16_t*)(p.ws + WS_MIX), (const bf16_t*)(p.ws + WS_WOUT), T_, 1024, 1024}; pg8::StaticOrder S; S.init(T_, 1024, gridDim.x, blockIdx.x);
        EpiG2 e{(const bf16_t*)(p.ws + WS_H0B), (bf16_t*)(p.ws + WS_HCAT)}; pg8::gemm_phase((PG8_LAS unsigned char*)smem, g, S, e); }
    if (ph == 5) phase_ln1(p);
    if (ph == 6) { pg8::Gemm g{(const bf16_t*)(p.ws + WS_H0B), (const bf16_t*)(p.ws + WS_WQ), T_, 2048, 1024}; pg8::StaticOrder S; S.init(T_, 2048, gridDim.x, blockIdx.x);
        EpiG3 e{(bf16_t*)(p.ws + WS_HCAT), 2048}; pg8::gemm_phase((PG8_LAS unsigned char*)smem, g, S, e); }
    if (ph == 7) phase_topk(p, smem);
    if (ph == 8) phase_gather2(p, smem);
}

constexpr int PROBE_PH = -1;
constexpr int LDS_BYTES = G2_LDS_BYTES;
__global__ void __launch_bounds__(NTHREADS, 2) k_mega(Params p) {
    extern __shared__ __attribute__((aligned(16))) unsigned char smem[];
    volatile LAS unsigned* st = (volatile LAS unsigned*)(smem + LDS_BYTES - 16);
    if (threadIdx.x < 4) st[threadIdx.x] = 0u;
    __syncthreads();
    const XcdBarrier bar = xcd_barrier_post((unsigned*)(p.ws + WS_CTL), st);
    if (PROBE_PH == 0) run_phase(0, p, smem, true);
    run_phase(0, p, smem); xcd_barrier(bar);
    if (PROBE_PH == 1) run_phase(1, p, smem, true);
    run_phase(1, p, smem); xcd_barrier(bar);
    if (PROBE_PH == 2) run_phase(2, p, smem, true);
    run_phase(2, p, smem); xcd_barrier(bar);
    if (PROBE_PH == 4) run_phase(4, p, smem, true);
    run_phase(4, p, smem); xcd_barrier(bar);
    if (PROBE_PH == 5) run_phase(5, p, smem, true);
    run_phase(5, p, smem); xcd_barrier(bar);
    if (PROBE_PH == 6) run_phase(6, p, smem, true);
    run_phase(6, p, smem); xcd_barrier(bar);
    if (PROBE_PH == 7) run_phase(7, p, smem, true);
    run_phase(7, p, smem); xcd_barrier(bar);
    if (PROBE_PH == 8) run_phase(8, p, smem, true);
    run_phase(8, p, smem, false, nullptr);
}

extern "C" void kernel_launch(void* const* d_in, const int* in_sizes, int n_in, void* d_out, int out_size, void* d_ws, size_t ws_size, hipStream_t stream) {
    if (n_in != 16 || out_size != T_ * D_ || ws_size < WS_END) {
        fprintf(stderr, "kernel_launch: unexpected problem (n_in %d, out %d, ws %zu < %zu)\n", n_in, out_size, ws_size, (size_t)WS_END);
        return;
    }
    static int grid_blocks = 0;
    if (!grid_blocks) {
        int dev = 0, cus = 0, per_cu = 0;
        hipGetDevice(&dev);
        hipDeviceGetAttribute(&cus, hipDeviceAttributeMultiprocessorCount, dev);
        if (hipFuncSetAttribute((const void*)k_mega, hipFuncAttributeMaxDynamicSharedMemorySize, LDS_BYTES) != hipSuccess) { fprintf(stderr, "kernel_launch: hipFuncSetAttribute failed\n"); grid_blocks = -1; return; }
        (void)hipOccupancyMaxActiveBlocksPerMultiprocessor(&per_cu, (const void*)k_mega, NTHREADS, LDS_BYTES);
        if (per_cu < 1) { fprintf(stderr, "kernel_launch: occupancy query says %d blocks per CU\n", per_cu); grid_blocks = -1; }
        else grid_blocks = cus;
    }
    if (grid_blocks < 0) return;
    Params p{};
    p.x = (const float*)d_in[0]; p.ln0_g = (const float*)d_in[1]; p.ln0_b = (const float*)d_in[2]; p.w_in = (const float*)d_in[3];
    p.pool_w = (const float*)d_in[4]; p.pool_b = (const float*)d_in[5]; p.pool_scale = (const float*)d_in[6]; p.w_out = (const float*)d_in[7];
    p.ln1_g = (const float*)d_in[8]; p.ln1_b = (const float*)d_in[9]; p.wq = (const float*)d_in[10]; p.subk = (const float*)d_in[11];
    p.pu = (const float*)d_in[12]; p.pv = (const float*)d_in[13]; p.ln2_g = (const float*)d_in[14]; p.ln2_b = (const float*)d_in[15];
    p.out = (float*)d_out; p.ws = (unsigned char*)d_ws;
    (void)hipMemsetAsync((unsigned char*)d_ws + WS_CTL, 0, 16384, stream);
    void* args[] = {&p};
    hipError_t e = hipLaunchCooperativeKernel((const void*)k_mega, dim3(grid_blocks), dim3(NTHREADS), args, LDS_BYTES, stream);
    if (e != hipSuccess) fprintf(stderr, "kernel_launch: cooperative launch failed: %s (grid %d)\n", hipGetErrorString(e), grid_blocks);
}
```

```cpp
#include <hip/hip_runtime.h>
#include <hip/hip_cooperative_groups.h>
#include <cstdio>
#include <cstdint>

namespace cg = cooperative_groups;

typedef unsigned short bf16_t;
typedef short bf16x8 __attribute__((ext_vector_type(8)));
typedef float f32x4 __attribute__((ext_vector_type(4)));
typedef float f32x16 __attribute__((ext_vector_type(16)));
typedef unsigned u32x4 __attribute__((ext_vector_type(4)));
typedef unsigned u32x2 __attribute__((ext_vector_type(2)));

constexpr int T_ = 16384, D_ = 1024, S_ = 2048;
constexpr int NTHREADS = 512, NWAVES = 8;
constexpr float LN_EPS = 1e-5f;
constexpr float DN_ALPHA = 1.189207115002721f;

constexpr size_t MB = 1024 * 1024;
constexpr size_t WS_CTL = 0;
constexpr size_t WS_H0B = 64 * 1024;
constexpr size_t WS_WIN = WS_H0B + 32 * MB;
constexpr size_t WS_WOUT = WS_WIN + 4 * MB;
constexpr size_t WS_WQ = WS_WOUT + 2 * MB;
constexpr size_t WS_POOLW = WS_WQ + 4 * MB;
constexpr size_t WS_SUBK = WS_POOLW + 256 * 1024;
constexpr size_t WS_UB = WS_SUBK + 64 * 1024;
constexpr size_t WS_U8 = WS_UB, WS_V8 = WS_UB + 16 * MB;
constexpr size_t WS_VB = WS_UB + 32 * MB;
constexpr size_t WS_SU = WS_VB, WS_SV = WS_VB + 64 * 1024;
constexpr size_t WS_HCAT = WS_VB + 32 * MB;
constexpr size_t WS_VT = WS_HCAT + 48 * MB;
constexpr size_t WS_MIX = WS_VT + 16 * MB;
constexpr size_t WS_POOLED = WS_MIX + 32 * MB;
constexpr size_t WS_END = WS_POOLED + 16 * MB;

struct Params {
    const float *x, *ln0_g, *ln0_b, *w_in, *pool_w, *pool_b, *pool_scale, *w_out, *ln1_g, *ln1_b, *wq, *subk, *pu, *pv, *ln2_g, *ln2_b;
    float* out;
    unsigned char* ws;
};

typedef float f32x2 __attribute__((ext_vector_type(2)));
typedef __bf16 bf16x2n __attribute__((ext_vector_type(2)));
__device__ __forceinline__ unsigned pk_bf16(float lo, float hi) { const f32x2 v = {lo, hi}; return __builtin_bit_cast(unsigned, __builtin_convertvector(v, bf16x2n)); }
__device__ __forceinline__ bf16_t f2bf(float f) { return (bf16_t)(pk_bf16(f, 0.f) & 0xffffu); }
__device__ __forceinline__ float bf_lo(unsigned u) { return __uint_as_float(u << 16); }
__device__ __forceinline__ float bf_hi(unsigned u) { return __uint_as_float(u & 0xffff0000u); }
template <int CTRL> __device__ __forceinline__ float dpp_f(float x) { return __int_as_float(__builtin_amdgcn_update_dpp(0, __float_as_int(x), CTRL, 0xF, 0xF, true)); }
__device__ __forceinline__ float row_sum16(float x) { x += dpp_f<0x128>(x); x += dpp_f<0x124>(x); x += dpp_f<0x122>(x); x += dpp_f<0x121>(x); return x; }
__device__ __forceinline__ float swap16_add(float a, float b) { const auto q = __builtin_amdgcn_permlane16_swap(__float_as_uint(a), __float_as_uint(b), false, false); return __uint_as_float(q[0]) + __uint_as_float(q[1]); }
__device__ __forceinline__ float swap32_add(float a, float b) { const auto q = __builtin_amdgcn_permlane32_swap(__float_as_uint(a), __float_as_uint(b), false, false); return __uint_as_float(q[0]) + __uint_as_float(q[1]); }
__device__ __forceinline__ float wave_sum(float v) { v = row_sum16(v); v = swap16_add(v, v); return swap32_add(v, v); }

__device__ __forceinline__ void ln_row(const float* src, const float* g, const float* b, float* dst32, bf16_t* dst16, int lane) {
    f32x4 v[4];
    float s = 0.f;
#pragma unroll
    for (int i = 0; i < 4; ++i) { v[i] = *(const f32x4*)(src + lane * 4 + i * 256); s += (v[i][0] + v[i][1]) + (v[i][2] + v[i][3]); }
    const float mean = wave_sum(s) * (1.0f / 1024.0f);
    float q = 0.f;
#pragma unroll
    for (int i = 0; i < 4; ++i) { f32x4 d = v[i] - mean; q += (d[0] * d[0] + d[1] * d[1]) + (d[2] * d[2] + d[3] * d[3]); }
    const float rstd = rsqrtf(wave_sum(q) * (1.0f / 1024.0f) + LN_EPS);
#pragma unroll
    for (int i = 0; i < 4; ++i) {
        const f32x4 gg = *(const f32x4*)(g + lane * 4 + i * 256), bb = *(const f32x4*)(b + lane * 4 + i * 256);
        const f32x4 y = (v[i] - mean) * rstd * gg + bb;
        if (dst32) *(f32x4*)(dst32 + lane * 4 + i * 256) = y;
        if (dst16) { u32x2 o; o.x = pk_bf16(y[0], y[1]); o.y = pk_bf16(y[2], y[3]); *(u32x2*)(dst16 + lane * 4 + i * 256) = o; }
    }
}

__device__ __forceinline__ void ln_rows4(const float* src, size_t rstride, const float* g, const float* b, bf16_t* dst16, int lane) {
    f32x4 v[4][4];
#pragma unroll
    for (int j = 0; j < 4; ++j)
#pragma unroll
        for (int i = 0; i < 4; ++i) v[j][i] = *(const f32x4*)(src + j * rstride + lane * 4 + i * 256);
    f32x4 gg[4], bb[4];
#pragma unroll
    for (int i = 0; i < 4; ++i) { gg[i] = *(const f32x4*)(g + lane * 4 + i * 256); bb[i] = *(const f32x4*)(b + lane * 4 + i * 256); }
#pragma unroll
    for (int j = 0; j < 4; ++j) {
        float s = 0.f;
#pragma unroll
        for (int i = 0; i < 4; ++i) s += (v[j][i][0] + v[j][i][1]) + (v[j][i][2] + v[j][i][3]);
        const float mean = wave_sum(s) * (1.0f / 1024.0f);
        float q = 0.f;
#pragma unroll
        for (int i = 0; i < 4; ++i) { const f32x4 d = v[j][i] - mean; q += (d[0] * d[0] + d[1] * d[1]) + (d[2] * d[2] + d[3] * d[3]); }
        const float rstd = rsqrtf(wave_sum(q) * (1.0f / 1024.0f) + LN_EPS);
#pragma unroll
        for (int i = 0; i < 4; ++i) {
            const f32x4 y = (v[j][i] - mean) * rstd * gg[i] + bb[i];
            u32x2 o; o.x = pk_bf16(y[0], y[1]); o.y = pk_bf16(y[2], y[3]); *(u32x2*)(dst16 + j * rstride + lane * 4 + i * 256) = o;
        }
    }
}

__device__ __forceinline__ void transpose_tile_wave(const float* W, int N, int k0, int n0, bf16_t* Wt, int ldt, int nout0, int kout0, float* tile  , int lane) {
    float v[64];
#pragma unroll
    for (int k = 0; k < 64; ++k) v[k] = W[(size_t)(k0 + k) * N + n0 + lane];
#pragma unroll
    for (int k = 0; k < 64; ++k) tile[k * 65 + lane] = v[k];
    asm volatile("s_waitcnt lgkmcnt(0)" ::: "memory");
#pragma unroll
    for (int n = 0; n < 64; ++n) Wt[(size_t)(nout0 + n) * ldt + kout0 + lane] = f2bf(tile[lane * 65 + n]);
    asm volatile("s_waitcnt lgkmcnt(0)" ::: "memory");
}

__device__ __forceinline__ unsigned q8x4(float a, float b, float c, float d) {
    unsigned w = 0;
    w = __builtin_amdgcn_cvt_pk_u8_f32(__builtin_rintf(a) + 128.f, 0, w); w = __builtin_amdgcn_cvt_pk_u8_f32(__builtin_rintf(b) + 128.f, 1, w);
    w = __builtin_amdgcn_cvt_pk_u8_f32(__builtin_rintf(c) + 128.f, 2, w); w = __builtin_amdgcn_cvt_pk_u8_f32(__builtin_rintf(d) + 128.f, 3, w);
    return w ^ 0x80808080u;
}
__device__ __forceinline__ void convert_table_rows4(const Params& p, int r0, int lane) {
    const int tbl = r0 >> 14, row0 = r0 & 16383;
    const float* src = (tbl ? p.pv : p.pu) + (size_t)row0 * 1024 + 4 * lane;
    f32x4 v[4][4];
#pragma unroll
    for (int j = 0; j < 4; ++j)
#pragma unroll
        for (int i = 0; i < 4; ++i) v[j][i] = *(const f32x4*)(src + (size_t)j * 1024 + 256 * i);
#pragma unroll
    for (int j = 0; j < 4; ++j) {
        float amax = 0.f;
#pragma unroll
        for (int i = 0; i < 4; ++i) amax = fmaxf(amax, fmaxf(fmaxf(fabsf(v[j][i][0]), fabsf(v[j][i][1])), fmaxf(fabsf(v[j][i][2]), fabsf(v[j][i][3]))));
#pragma unroll
        for (int o = 32; o > 0; o >>= 1) amax = fmaxf(amax, __shfl_xor(amax, o));
        const float top = tbl ? 416.0f : 127.0f;
        const float sc = amax > 0.f ? top / amax : 1.0f, inv = amax > 0.f ? amax / top : 1.0f;
        u32x4 w;
        if (tbl) {
#pragma unroll
            for (int i = 0; i < 4; ++i) { int t = __builtin_amdgcn_cvt_pk_fp8_f32(v[j][i][0] * sc, v[j][i][1] * sc, 0, false); t = __builtin_amdgcn_cvt_pk_fp8_f32(v[j][i][2] * sc, v[j][i][3] * sc, t, true); w[i] = (unsigned)t; }
        } else {
#pragma unroll
            for (int i = 0; i < 4; ++i) w[i] = q8x4(v[j][i][0] * sc, v[j][i][1] * sc, v[j][i][2] * sc, v[j][i][3] * sc);
        }
#pragma unroll
        for (int i = 0; i < 4; ++i) *(unsigned*)(p.ws + (tbl ? WS_V8 : WS_U8) + (size_t)(row0 + j) * 1024 + 256 * i + 4 * lane) = w[i];
        if (lane == 0) ((float*)(p.ws + WS_SU))[2 * (row0 + j) + tbl] = inv;
    }
}

__device__ void phase_prep(const Params& p, unsigned char* smem) {
    const int tid = threadIdx.x, lane = tid & 63, wid = tid >> 6;
    const int gw = blockIdx.x * NWAVES + wid, nw = gridDim.x * NWAVES;
    const size_t gtid = (size_t)blockIdx.x * NTHREADS + tid, nthr = (size_t)gridDim.x * NTHREADS;
    bf16_t* h0b = (bf16_t*)(p.ws + WS_H0B);
    for (int r = gw; r + 3 * nw < T_; r += 4 * nw) ln_rows4(p.x + (size_t)r * D_, (size_t)nw * D_, p.ln0_g, p.ln0_b, h0b + (size_t)r * D_, lane);
    if (T_ % (4 * nw) != 0) for (int r = gw + (T_ / (4 * nw)) * 4 * nw; r < T_; r += nw) ln_row(p.x + (size_t)r * D_, p.ln0_g, p.ln0_b, nullptr, h0b + (size_t)r * D_, lane);
    {
        u32x2* sk = (u32x2*)(p.ws + WS_SUBK);
        for (size_t i = gtid; i < 2 * 128 * 128 / 4; i += nthr) { const f32x4 a = ((const f32x4*)p.subk)[i]; u32x2 o; o.x = pk_bf16(a[0], a[1]); o.y = pk_bf16(a[2], a[3]); sk[i] = o; }
        bf16_t* pw = (bf16_t*)(p.ws + WS_POOLW);
        for (size_t i = gtid; i < 2 * 2 * 128 * 128; i += nthr) {
            const int half = (int)(i >> 15), blk = (int)((i >> 14) & 1), r = (int)((i >> 7) & 127), c = (int)(i & 127);
            pw[(size_t)half * 65536 + (size_t)(blk * 128 + r) * 256 + ((1 - blk) * 128 + c)] = 0;
        }
    }
    float* tile = (float*)smem + wid * (64 * 65);
    constexpr int T_IN = 16 * 32, T_OUT = 16 * 16, T_Q = 16 * 32, T_POOL = 16;
    for (int it = gw; it < T_IN + T_OUT + T_Q + T_POOL; it += nw) {
        if (it < T_IN) { const int kt = it >> 5, nt = it & 31; transpose_tile_wave(p.w_in, 2048, kt * 64, nt * 64, (bf16_t*)(p.ws + WS_WIN), 1024, nt * 64, kt * 64, tile, lane); }
        else if (it < T_IN + T_OUT) { const int j = it - T_IN, kt = j >> 4, nt = j & 15; transpose_tile_wave(p.w_out, 1024, kt * 64, nt * 64, (bf16_t*)(p.ws + WS_WOUT), 1024, nt * 64, kt * 64, tile, lane); }
        else if (it < T_IN + T_OUT + T_Q) { const int j = it - T_IN - T_OUT, kt = j >> 5, nt = j & 31; transpose_tile_wave(p.wq, 2048, kt * 64, nt * 64, (bf16_t*)(p.ws + WS_WQ), 1024, nt * 64, kt * 64, tile, lane); }
        else { const int j = it - T_IN - T_OUT - T_Q, g = j >> 2, kt = (j >> 1) & 1, nt = j & 1, half = g >> 1, gg = g & 1;
            transpose_tile_wave(p.pool_w + (size_t)g * 128 * 128, 128, kt * 64, nt * 64, (bf16_t*)(p.ws + WS_POOLW) + (size_t)half * 65536, 256, gg * 128 + nt * 64, gg * 128 + kt * 64, tile, lane); }
    }
}

constexpr int BM = 128, BN = 256, BK = 64, LDT = 72;
constexpr int GEMM_LDS_BYTES = (BM + BN) * LDT * 2;

template <class Epi>
__device__ void gemm_phase(const bf16_t* A, int lda, long strideA, const bf16_t* Bt, int ldb, long strideB, int M, int N, int K, int nbatch, const Epi& epi, unsigned char* smem) {
    bf16_t* As = (bf16_t*)smem; bf16_t* Bs = As + BM * LDT;
    const int tid = threadIdx.x, lane = tid & 63, wid = tid >> 6, wr = wid >> 2, wc = wid & 3, fr = lane & 15, fq = lane >> 4;
    const int ntm = M / BM, ntn = N / BN, tiles_per = ntm * ntn, total = tiles_per * nbatch, nk = K / BK;
    const int lrow = tid >> 3, lch = tid & 7;
    for (int tile = blockIdx.x; tile < total; tile += gridDim.x) {
        const int bz = tile / tiles_per, tt = tile - bz * tiles_per, tm = tt / ntn, tn = tt - tm * ntn;
        const bf16_t* Ab = A + (size_t)bz * strideA + (size_t)(tm * BM + lrow) * lda + lch * 8;
        const bf16_t* Bb = Bt + (size_t)bz * strideB + (size_t)(tn * BN + lrow) * ldb + lch * 8;
        u32x4 ra[2], rb[4];
#pragma unroll
        for (int i = 0; i < 2; ++i) ra[i] = *(const u32x4*)(Ab + (size_t)(64 * i) * lda);
#pragma unroll
        for (int i = 0; i < 4; ++i) rb[i] = *(const u32x4*)(Bb + (size_t)(64 * i) * ldb);
        f32x4 acc[4][4];
#pragma unroll
        for (int m = 0; m < 4; ++m)
#pragma unroll
            for (int n = 0; n < 4; ++n) acc[m][n] = (f32x4){0.f, 0.f, 0.f, 0.f};
        for (int kt = 0; kt < nk; ++kt) {
            __syncthreads();
#pragma unroll
            for (int i = 0; i < 2; ++i) *(u32x4*)(As + (lrow + 64 * i) * LDT + lch * 8) = ra[i];
#pragma unroll
            for (int i = 0; i < 4; ++i) *(u32x4*)(Bs + (lrow + 64 * i) * LDT + lch * 8) = rb[i];
            __syncthreads();
            if (kt + 1 < nk) {
#pragma unroll
                for (int i = 0; i < 2; ++i) ra[i] = *(const u32x4*)(Ab + (size_t)(64 * i) * lda + (kt + 1) * BK);
#pragma unroll
                for (int i = 0; i < 4; ++i) rb[i] = *(const u32x4*)(Bb + (size_t)(64 * i) * ldb + (kt + 1) * BK);
            }
#pragma unroll
            for (int ks = 0; ks < 2; ++ks) {
                bf16x8 af[4], bfr[4];
#pragma unroll
                for (int m = 0; m < 4; ++m) af[m] = *(const bf16x8*)(As + (wr * 64 + m * 16 + fr) * LDT + ks * 32 + fq * 8);
#pragma unroll
                for (int n = 0; n < 4; ++n) bfr[n] = *(const bf16x8*)(Bs + (wc * 64 + n * 16 + fr) * LDT + ks * 32 + fq * 8);
#pragma unroll
                for (int m = 0; m < 4; ++m)
#pragma unroll
                    for (int n = 0; n < 4; ++n) acc[m][n] = __builtin_amdgcn_mfma_f32_16x16x32_bf16(bfr[n], af[m], acc[m][n], 0, 0, 0);
            }
        }
#pragma unroll
        for (int m = 0; m < 4; ++m)
#pragma unroll
            for (int n = 0; n < 4; ++n) epi(bz, tm * BM + wr * 64 + m * 16 + fr, tn * BN + wc * 64 + n * 16 + fq * 4, acc[m][n]);
    }
}

struct EpiPool {
    bf16_t* mix; const float* pb; const float* ps;
    __device__ __forceinline__ void operator()(int bz, int row, int col, f32x4 v) const {
        const int gc = bz * 256 + col;
        const f32x4 b = *(const f32x4*)(pb + gc), s = *(const f32x4*)(ps + gc);
        const f32x4 y = (v + b) * s;
        u32x2 o; o.x = pk_bf16(y[0], y[1]); o.y = pk_bf16(y[2], y[3]); *(u32x2*)(mix + (size_t)row * 1024 + gc) = o;
    }
};
namespace pg8 {
#define PG8_LAS __attribute__((address_space(3)))
constexpr int BM = 256, BK = 64, HALF = 128, HTB = HALF * BK * 2  , STAGE_BYTES = 8 * HTB, NXCD = 8, WGM = 8;
__host__ __device__ __forceinline__ int lds_byte(int r, int c) { const int st = (r >> 4) * 2 + (c >> 5), rr = r & 15, cc = c & 31, ob = rr * 64 + cc * 2; return st * 1024 + (ob ^ (((ob >> 9) & 1) << 5)); }
__host__ __device__ __forceinline__ void stage_rc(int b, int& R, int& C) { const int st = b / 1024, sb = b % 1024, swz = sb ^ (((sb >> 9) & 1) << 5); R = (st >> 1) * 16 + swz / 64; C = (st & 1) * 32 + (swz % 64) / 2; }
__host__ __device__ __forceinline__ int perm32(int rho) { const int n = rho >> 4, i = rho & 15; return 8 * (i >> 2) + 4 * n + (i & 3); }
struct Unit { int pm, pn; };
struct Gemm { const bf16_t* A; const bf16_t* Bt; int M, N, K; };
struct StaticOrder {
    int nM, nN, nwg, G, c;
    __host__ __device__ void init(int M, int N, int G_, int c_) { nM = M / BM; nN = N / BM; nwg = nM * nN; G = G_; c = c_; }
    __host__ __device__ bool next(int i, Unit& u) const {
        const long L = (long)i * G + c; if (L >= nwg) return false;
        int wgid = (int)L; { const int q = nwg / NXCD, r = nwg % NXCD, xcd = wgid % NXCD, off = wgid / NXCD; wgid = (xcd < r ? xcd * (q + 1) : r * (q + 1) + (xcd - r) * q) + off; }
        const int nig = WGM * nN, gid = wgid / nig, fm = gid * WGM, gsz = (nM - fm) < WGM ? (nM - fm) : WGM;
        u.pm = fm + ((wgid % nig) % gsz); u.pn = (wgid % nig) / gsz; return true;
    }
    __device__ __forceinline__ void a_ready(const Unit&) const {}
    __device__ __forceinline__ void done(const Unit&) const {}
};
template <class Epi, class Sched>
__device__ __forceinline__ void gemm_phase(PG8_LAS unsigned char* lds, const Gemm g, const Sched& S, const Epi& E) {
    const int tid = threadIdx.x, wid = __builtin_amdgcn_readfirstlane(tid >> 6), lane = tid & 63, wr = wid >> 2, wc = wid & 3, fr = lane & 15, fq = lane >> 4;
    const int K = g.K, nt = K / BK;
    unsigned voffA[2], voffB[2];
#pragma unroll
    for (int i = 0; i < 2; ++i) { int R, C; stage_rc(tid * 16 + i * 8192, R, C); const int Rb = Epi::PERM ? ((R & ~31) + perm32(R & 31)) : R;
        voffA[i] = (unsigned)(R * K + C) * 2u; voffB[i] = (unsigned)(Rb * K + C) * 2u; }
    const size_t kstep = (size_t)(BK * 2);
    const size_t hstep = (size_t)HALF * K * 2;
    const size_t tstep = 2 * hstep;
    const unsigned ldsw = (unsigned)wid * 1024u;
    const int aoff = lds_byte(wr * 64 + fr, fq * 8), boff = lds_byte(wc * 32 + fr, fq * 8);
#define PG8_SA(b, h) (((b) * 2 + (h)) * HTB)
#define PG8_SB(b, h) ((4 + (b) * 2 + (h)) * HTB)
#define PG8_STAGE(bufoff, gbase, voff) do { _Pragma("unroll") for (int _i = 0; _i < 2; ++_i) \
        __builtin_amdgcn_global_load_lds((const unsigned*)((const char*)(gbase) + (voff)[_i]), (PG8_LAS unsigned*)(lds + (bufoff) + ldsw + _i * 8192), 16, 0, 0); } while (0)
#define PG8_LDA(dst, b, h) do { _Pragma("unroll") for (int m = 0; m < 4; ++m) _Pragma("unroll") for (int k = 0; k < 2; ++k) dst[m][k] = *(const PG8_LAS bf16x8*)(lds + PG8_SA(b, h) + aoff + m * 2048 + k * 1024); } while (0)
#define PG8_LDB(dst, b, h) do { _Pragma("unroll") for (int n = 0; n < 2; ++n) _Pragma("unroll") for (int k = 0; k < 2; ++k) dst[n][k] = *(const PG8_LAS bf16x8*)(lds + PG8_SB(b, h) + boff + n * 2048 + k * 1024); } while (0)
#define PG8_MMA(ai, bj, At, Bt) do { __builtin_amdgcn_s_setprio(1); _Pragma("unroll") for (int m = 0; m < 4; ++m) _Pragma("unroll") for (int n = 0; n < 2; ++n) _Pragma("unroll") for (int k = 0; k < 2; ++k) \
        acc[ai][bj][m][n] = __builtin_amdgcn_mfma_f32_16x16x32_bf16(Bt[n][k], At[m][k], acc[ai][bj][m][n], 0, 0, 0); __builtin_amdgcn_s_setprio(0); } while (0)
#define PG8_WAIT_V(n) asm volatile("s_waitcnt vmcnt(" #n ")" ::: "memory")
#define PG8_WAIT_L(n) asm volatile("s_waitcnt lgkmcnt(" #n ")" ::: "memory")
#define PG8_BAR __builtin_amdgcn_s_barrier()
#define PG8_SCHED __builtin_amdgcn_sched_barrier(0)
    Unit cur, nxt; int ui = 0;
    if (!S.next(0, cur)) return;
    f32x4 acc[2][2][4][2];
#pragma unroll
    for (int a = 0; a < 2; ++a)
#pragma unroll
        for (int b = 0; b < 2; ++b)
#pragma unroll
            for (int m = 0; m < 4; ++m)
#pragma unroll
                for (int n = 0; n < 2; ++n) acc[a][b][m][n] = (f32x4){0.f, 0.f, 0.f, 0.f};
    bf16x8 At[4][2], B0[2][2], B1[2][2];
    const char* cA = (const char*)g.A + (size_t)cur.pm * tstep; const char* cB = (const char*)g.Bt + (size_t)cur.pn * tstep;
    S.a_ready(cur);
    PG8_STAGE(PG8_SB(0, 0), cB, voffB); PG8_STAGE(PG8_SA(0, 0), cA, voffA); PG8_STAGE(PG8_SB(0, 1), cB + hstep, voffB); PG8_STAGE(PG8_SA(0, 1), cA + hstep, voffA);
    if (wr == 1) PG8_BAR;
    PG8_WAIT_V(4); PG8_BAR;
    PG8_STAGE(PG8_SB(1, 0), cB + kstep, voffB); PG8_STAGE(PG8_SA(1, 0), cA + kstep, voffA); PG8_STAGE(PG8_SB(1, 1), cB + hstep + kstep, voffB);
    PG8_WAIT_V(6); PG8_BAR;
    for (;;) {
        const bool has_next = S.next(ui + 1, nxt);
        const char* nA = has_next ? (const char*)g.A + (size_t)nxt.pm * tstep : cA; const char* nB = has_next ? (const char*)g.Bt + (size_t)nxt.pn * tstep : cB;
        for (int t = 0; t < nt; t += 2) {
            const bool last = (t == nt - 2);
            const char* a1 = cA + (size_t)(t + 1) * kstep;
            const char* a2 = last ? nA : cA + (size_t)(t + 2) * kstep; const char* b2 = last ? nB : cB + (size_t)(t + 2) * kstep;
            const char* a3 = a2 + kstep; const char* b3 = b2 + kstep;
            if (last && has_next) S.a_ready(nxt);
            PG8_LDB(B0, 0, 0); PG8_SCHED; PG8_LDA(At, 0, 0); PG8_STAGE(PG8_SA(1, 1), a1 + hstep, voffA);
            PG8_WAIT_L(8); PG8_BAR; PG8_WAIT_L(0); PG8_MMA(0, 0, At, B0); PG8_BAR; PG8_SCHED;
            PG8_LDB(B1, 0, 1); PG8_STAGE(PG8_SB(0, 0), b2, voffB);
            PG8_BAR; PG8_WAIT_L(0); PG8_MMA(0, 1, At, B1); PG8_BAR;
            PG8_LDA(At, 0, 1); PG8_STAGE(PG8_SA(0, 0), a2, voffA);
            PG8_BAR; PG8_WAIT_L(0); PG8_MMA(1, 0, At, B0); PG8_BAR; PG8_SCHED;
            PG8_STAGE(PG8_SB(0, 1), b2 + hstep, voffB);
            PG8_WAIT_V(6); PG8_BAR; PG8_MMA(1, 1, At, B1); PG8_BAR;
            PG8_LDB(B0, 1, 0); PG8_SCHED; PG8_LDA(At, 1, 0); PG8_STAGE(PG8_SA(0, 1), a2 + hstep, voffA);
            PG8_WAIT_L(8); PG8_BAR; PG8_WAIT_L(0); PG8_MMA(0, 0, At, B0); PG8_BAR; PG8_SCHED;
            PG8_LDB(B1, 1, 1); PG8_STAGE(PG8_SB(1, 0), b3, voffB);
            PG8_BAR; PG8_WAIT_L(0); PG8_MMA(0, 1, At, B1); PG8_BAR;
            PG8_LDA(At, 1, 1); PG8_STAGE(PG8_SA(1, 0), a3, voffA);
            PG8_BAR; PG8_WAIT_L(0); PG8_MMA(1, 0, At, B0); PG8_BAR; PG8_SCHED;
            PG8_STAGE(PG8_SB(1, 1), b3 + hstep, voffB);
            PG8_WAIT_V(6); PG8_BAR; PG8_MMA(1, 1, At, B1); PG8_BAR;
        }
        E(acc, cur, wr, wc, fr, fq); S.done(cur);
        if (!has_next) break;
#pragma unroll
        for (int a = 0; a < 2; ++a)
#pragma unroll
            for (int b = 0; b < 2; ++b)
#pragma unroll
                for (int m = 0; m < 4; ++m)
#pragma unroll
                    for (int n = 0; n < 2; ++n) acc[a][b][m][n] = (f32x4){0.f, 0.f, 0.f, 0.f};
        cur = nxt; cA = nA; cB = nB; ++ui;
    }
    PG8_WAIT_V(0);
    if (wr == 0) PG8_BAR;
    PG8_BAR;
#undef PG8_SA
#undef PG8_SB
#undef PG8_STAGE
#undef PG8_LDA
#undef PG8_LDB
#undef PG8_MMA
#undef PG8_WAIT_V
#undef PG8_WAIT_L
#undef PG8_BAR
#undef PG8_SCHED
}
}

struct EpiG1 {
    static constexpr bool PERM = true, AFTER_DRAIN = false;
    bf16_t* hcat; bf16_t* vT;
    __device__ __forceinline__ void operator()(const f32x4 (&acc)[2][2][4][2], const pg8::Unit& u, int wr, int wc, int fr, int fq) const {
        const int row0 = u.pm * 256 + wr * 64 + fr, col0 = u.pn * 256 + wc * 32 + 8 * fq;
#pragma unroll
        for (int ai = 0; ai < 2; ++ai)
#pragma unroll
            for (int m = 0; m < 4; ++m) {
                const int row = row0 + ai * 128 + m * 16;
#pragma unroll
                for (int bj = 0; bj < 2; ++bj) {
                    const int col = col0 + bj * 128; const f32x4 v0 = acc[ai][bj][m][0], v1 = acc[ai][bj][m][1];
                    if (u.pn < 6) { u32x4 w; w.x = pk_bf16(v0[0], v0[1]); w.y = pk_bf16(v0[2], v0[3]); w.z = pk_bf16(v1[0], v1[1]); w.w = pk_bf16(v1[2], v1[3]); *(u32x4*)(hcat + (size_t)row * 1536 + col) = w; }
                    else {
                        const int c = col - 1536, hh = c >> 6, d = c & 63, b = row >> 11, s = row & 2047;
                        bf16_t* dst = vT + ((size_t)((b * 8 + hh) * 64 + d)) * 2048 + s;
#pragma unroll
                        for (int j = 0; j < 4; ++j) { dst[(size_t)j * 2048] = f2bf(v0[j]); dst[(size_t)(4 + j) * 2048] = f2bf(v1[j]); }
                    }
                }
            }
    }
};
struct EpiG2 {
    static constexpr bool PERM = true, AFTER_DRAIN = false;
    const bf16_t* h0b; bf16_t* y1;
    __device__ __forceinline__ void operator()(const f32x4 (&acc)[2][2][4][2], const pg8::Unit& u, int wr, int wc, int fr, int fq) const {
        const int row0 = u.pm * 256 + wr * 64 + fr, col0 = u.pn * 256 + wc * 32 + 8 * fq;
#pragma unroll
        for (int ai = 0; ai < 2; ++ai)
#pragma unroll
            for (int m = 0; m < 4; ++m) {
                const int row = row0 + ai * 128 + m * 16;
#pragma unroll
                for (int bj = 0; bj < 2; ++bj) {
                    const int col = col0 + bj * 128; const f32x4 v0 = acc[ai][bj][m][0], v1 = acc[ai][bj][m][1];
                    const u32x4 h = *(const u32x4*)(h0b + (size_t)row * 1024 + col);
                    u32x4 w;
                    w.x = pk_bf16(DN_ALPHA * bf_lo(h.x) + v0[0], DN_ALPHA * bf_hi(h.x) + v0[1]); w.y = pk_bf16(DN_ALPHA * bf_lo(h.y) + v0[2], DN_ALPHA * bf_hi(h.y) + v0[3]);
                    w.z = pk_bf16(DN_ALPHA * bf_lo(h.z) + v1[0], DN_ALPHA * bf_hi(h.z) + v1[1]); w.w = pk_bf16(DN_ALPHA * bf_lo(h.w) + v1[2], DN_ALPHA * bf_hi(h.w) + v1[3]);
                    *(u32x4*)(y1 + (size_t)row * 1024 + col) = w;
                }
            }
    }
};
struct EpiG3 {
    static constexpr bool PERM = true, AFTER_DRAIN = false;
    bf16_t* C; int ldc;
    __device__ __forceinline__ void operator()(const f32x4 (&acc)[2][2][4][2], const pg8::Unit& u, int wr, int wc, int fr, int fq) const {
        const int row0 = u.pm * 256 + wr * 64 + fr, col0 = u.pn * 256 + wc * 32 + 8 * fq;
#pragma unroll
        for (int ai = 0; ai < 2; ++ai)
#pragma unroll
            for (int m = 0; m < 4; ++m) {
                const int row = row0 + ai * 128 + m * 16;
#pragma unroll
                for (int bj = 0; bj < 2; ++bj) {
                    const int col = col0 + bj * 128; const f32x4 v0 = acc[ai][bj][m][0], v1 = acc[ai][bj][m][1];
                    u32x4 w; w.x = pk_bf16(v0[0], v0[1]); w.y = pk_bf16(v0[2], v0[3]); w.z = pk_bf16(v1[0], v1[1]); w.w = pk_bf16(v1[2], v1[3]);
                    *(u32x4*)(C + (size_t)row * ldc + col) = w;
                }
            }
    }
};

constexpr int ATT_HIST = 160, ATT_KEYS = 256 + ATT_HIST, ATT_KSTR = 72  , ATT_VSTR = ATT_KEYS + 8  ;
constexpr int ATT_K_BYTES = ATT_KEYS * ATT_KSTR * 2, ATT_LDS_BYTES = ATT_K_BYTES + 64 * ATT_VSTR * 2;
__device__ void phase_attn(const Params& p, unsigned char* smem) {
    const bf16_t* hcat = (const bf16_t*)(p.ws + WS_HCAT); const bf16_t* vT = (const bf16_t*)(p.ws + WS_VT); bf16_t* mix = (bf16_t*)(p.ws + WS_MIX);
    const int tid = threadIdx.x, lane = tid & 63, wid = tid >> 6, qi = lane & 31, hf = lane >> 5;
    bf16_t* Ks = (bf16_t*)smem; bf16_t* Vs = (bf16_t*)(smem + ATT_K_BYTES);
    for (int item = blockIdx.x; item < 512; item += gridDim.x) {
        const int c = item & 7, bh = item >> 3, b = bh >> 3, h = bh & 7;
        const int q0c = c * 256, lo = (q0c > ATT_HIST) ? q0c - ATT_HIST : 0, nkeys = q0c + 256 - lo;
        const size_t tb = (size_t)b * 2048;
        const int q0 = q0c + wid * 32, t = q0 + qi;
        bf16x8 qf[4];
        { const bf16_t* qrow = hcat + (tb + t) * 1536 + 512 + h * 64 + hf * 8;
#pragma unroll
          for (int s = 0; s < 4; ++s) qf[s] = *(const bf16x8*)(qrow + s * 16); }
        __syncthreads();
        {
            const int cpr = nkeys >> 3;
            u32x4 rk[7], rv[7];
#pragma unroll
            for (int j = 0; j < 7; ++j) { const int i = tid + NTHREADS * j; const int ic = (i < nkeys * 8) ? i : 0; const int key = ic >> 3, ch = ic & 7;
                rk[j] = *(const u32x4*)(hcat + (tb + lo + key) * 1536 + 1024 + h * 64 + ch * 8);
                const int d = ic / cpr, cv = ic - d * cpr;
                rv[j] = *(const u32x4*)(vT + (size_t)(bh * 64 + d) * 2048 + lo + cv * 8); }
#pragma unroll
            for (int j = 0; j < 7; ++j) { const int i = tid + NTHREADS * j; if (i < nkeys * 8) { const int key = i >> 3, ch = i & 7; *(u32x4*)(Ks + key * ATT_KSTR + ch * 8) = rk[j];
                const int d = i / cpr, cv = i - d * cpr; *(u32x4*)(Vs + d * ATT_VSTR + cv * 8) = rv[j]; } }
        }
        __syncthreads();
        f32x16 o0, o1;
#pragma unroll
        for (int r = 0; r < 16; ++r) { o0[r] = 0.f; o1[r] = 0.f; }
        float R = 0.f;
        const bf16_t* vbase = vT + (size_t)(bh * 64 + qi) * 2048 + 4 * hf;
        for (int k0 = q0; k0 >= 0; k0 -= 32) {
            bf16x8 kf[4], vf[2][2];
            if (k0 >= lo) {
                const int kl = k0 - lo;
                const bf16_t* kr = Ks + (kl + qi) * ATT_KSTR + hf * 8;
#pragma unroll
                for (int s = 0; s < 4; ++s) kf[s] = *(const bf16x8*)(kr + s * 16);
#pragma unroll
                for (int db = 0; db < 2; ++db)
#pragma unroll
                    for (int s = 0; s < 2; ++s) { const bf16_t* vr = Vs + (db * 32 + qi) * ATT_VSTR + kl + 16 * s + 4 * hf;
                        const u32x2 l = *(const u32x2*)vr, hh = *(const u32x2*)(vr + 8); u32x4 w; w.x = l.x; w.y = l.y; w.z = hh.x; w.w = hh.y; vf[db][s] = __builtin_bit_cast(bf16x8, w); }
            } else {
                const bf16_t* krow = hcat + (tb + k0 + qi) * 1536 + 1024 + h * 64 + hf * 8;
#pragma unroll
                for (int s = 0; s < 4; ++s) kf[s] = *(const bf16x8*)(krow + s * 16);
#pragma unroll
                for (int db = 0; db < 2; ++db)
#pragma unroll
                    for (int s = 0; s < 2; ++s) { const bf16_t* vr = vbase + (size_t)(db * 32) * 2048 + k0 + 16 * s;
                        const u32x2 l = *(const u32x2*)vr, hh = *(const u32x2*)(vr + 8); u32x4 w; w.x = l.x; w.y = l.y; w.z = hh.x; w.w = hh.y; vf[db][s] = __builtin_bit_cast(bf16x8, w); }
            }
            f32x16 sacc;
#pragma unroll
            for (int r = 0; r < 16; ++r) sacc[r] = 0.f;
#pragma unroll
            for (int s = 0; s < 4; ++s) sacc = __builtin_amdgcn_mfma_f32_32x32x16_bf16(kf[s], qf[s], sacc, 0, 0, 0);
            float zv[16], sfx[16], tot[4], ptot[4], after[4];
            const bool diag = (k0 == q0);
            unsigned vmask = 0xffffu;
            if (diag) { vmask = 0u;
#pragma unroll
                for (int r = 0; r < 16; ++r) vmask |= ((k0 + (r & 3) + 8 * (r >> 2) + 4 * hf) < t) ? (1u << r) : 0u; }
#pragma unroll
            for (int r = 0; r < 16; ++r) {
                const float z2 = sacc[r] * (0.125f * 1.44269504088896341f);
                const float sp2 = fmaxf(z2, 0.f) + __builtin_amdgcn_logf(1.f + __builtin_amdgcn_exp2f(-fabsf(z2)));
                zv[r] = z2; sfx[r] = (vmask >> r) & 1u ? -sp2 : 0.f;
            }
#pragma unroll
            for (int g = 0; g < 4; ++g) {
                sfx[4 * g + 2] += sfx[4 * g + 3]; sfx[4 * g + 1] += sfx[4 * g + 2]; sfx[4 * g] += sfx[4 * g + 1];
                tot[g] = sfx[4 * g];
            }
#pragma unroll
            for (int g = 0; g < 4; ++g) ptot[g] = __shfl_xor(tot[g], 32);
            float run = 0.f;
#pragma unroll
            for (int g = 3; g >= 0; --g) { after[g] = run + (hf == 0 ? ptot[g] : 0.f); run += tot[g] + ptot[g]; }
            unsigned apk[8];
#pragma unroll
            for (int r = 0; r < 16; r += 2) {
                const float e0 = __builtin_amdgcn_exp2f(zv[r] + sfx[r] + (after[r >> 2] + R)), e1 = __builtin_amdgcn_exp2f(zv[r + 1] + sfx[r + 1] + (after[(r + 1) >> 2] + R));
                apk[r >> 1] = pk_bf16((vmask >> r) & 1u ? e0 : 0.f, (vmask >> (r + 1)) & 1u ? e1 : 0.f);
            }
            R += run;
            u32x4 w0, w1; w0.x = apk[0]; w0.y = apk[1]; w0.z = apk[2]; w0.w = apk[3]; w1.x = apk[4]; w1.y = apk[5]; w1.z = apk[6]; w1.w = apk[7];
            const bf16x8 af0 = __builtin_bit_cast(bf16x8, w0), af1 = __builtin_bit_cast(bf16x8, w1);
            o0 = __builtin_amdgcn_mfma_f32_32x32x16_bf16(vf[0][0], af0, o0, 0, 0, 0);
            o0 = __builtin_amdgcn_mfma_f32_32x32x16_bf16(vf[0][1], af1, o0, 0, 0, 0);
            o1 = __builtin_amdgcn_mfma_f32_32x32x16_bf16(vf[1][0], af0, o1, 0, 0, 0);
            o1 = __builtin_amdgcn_mfma_f32_32x32x16_bf16(vf[1][1], af1, o1, 0, 0, 0);
            if (__all(R <= -127.0f)) break;
        }
        bf16_t* orow = mix + (tb + t) * 1024 + 512 + h * 64 + 4 * hf;
#pragma unroll
        for (int g = 0; g < 4; ++g) {
            u32x2 w; w.x = pk_bf16(o0[4 * g], o0[4 * g + 1]); w.y = pk_bf16(o0[4 * g + 2], o0[4 * g + 3]); *(u32x2*)(orow + 8 * g) = w;
            u32x2 w2; w2.x = pk_bf16(o1[4 * g], o1[4 * g + 1]); w2.y = pk_bf16(o1[4 * g + 2], o1[4 * g + 3]); *(u32x2*)(orow + 32 + 8 * g) = w2;
        }
    }
    __syncthreads();
}

template <int W> __device__ __forceinline__ void pool_item(const bf16_t* hcat, bf16_t* pooled, int t, int c8) {
    const int s = t & 2047, cnt = (s + 1 < W) ? (s + 1) : W;
    u32x4 v[W];
#pragma unroll
    for (int i = 0; i < W; ++i) { const int ti = t - ((i < cnt) ? i : (cnt - 1)); v[i] = *(const u32x4*)(hcat + (size_t)ti * 1536 + c8); }
    float acc[8];
#pragma unroll
    for (int j = 0; j < 8; ++j) acc[j] = 0.f;
#pragma unroll
    for (int i = 0; i < W; ++i) {
        const float wgt = (i < cnt) ? 1.f : 0.f;
        acc[0] += wgt * bf_lo(v[i].x); acc[1] += wgt * bf_hi(v[i].x); acc[2] += wgt * bf_lo(v[i].y); acc[3] += wgt * bf_hi(v[i].y);
        acc[4] += wgt * bf_lo(v[i].z); acc[5] += wgt * bf_hi(v[i].z); acc[6] += wgt * bf_lo(v[i].w); acc[7] += wgt * bf_hi(v[i].w);
    }
    const float inv = 1.0f / (float)cnt;
    u32x4 o; o.x = pk_bf16(acc[0] * inv - bf_lo(v[0].x), acc[1] * inv - bf_hi(v[0].x)); o.y = pk_bf16(acc[2] * inv - bf_lo(v[0].y), acc[3] * inv - bf_hi(v[0].y));
    o.z = pk_bf16(acc[4] * inv - bf_lo(v[0].z), acc[5] * inv - bf_hi(v[0].z)); o.w = pk_bf16(acc[6] * inv - bf_lo(v[0].w), acc[7] * inv - bf_hi(v[0].w));
    *(u32x4*)(pooled + (size_t)t * 512 + c8) = o;
}
__device__ void phase_poolprep(const Params& p) {
    const bf16_t* hcat = (const bf16_t*)(p.ws + WS_HCAT); bf16_t* pooled = (bf16_t*)(p.ws + WS_POOLED);
    const int lane = threadIdx.x & 63, wid = threadIdx.x >> 6;
    if (blockIdx.x >= 256) return;
    const int tm = blockIdx.x & 127, bz = blockIdx.x >> 7;
    for (int ii = wid; ii < 64; ii += NWAVES) {
        const int g = 2 * bz + (ii & 1), t = tm * 128 + (ii >> 1) * 4 + (lane >> 4), c8 = g * 128 + (lane & 15) * 8;
        if (g == 0) pool_item<2>(hcat, pooled, t, c8);
        else if (g == 1) pool_item<4>(hcat, pooled, t, c8);
        else if (g == 2) pool_item<8>(hcat, pooled, t, c8);
        else pool_item<16>(hcat, pooled, t, c8);
    }
}

__device__ void phase_ln1(const Params& p) {
    const int lane = threadIdx.x & 63, wid = threadIdx.x >> 6;
    const int gw = blockIdx.x * NWAVES + wid, nw = gridDim.x * NWAVES;
    const bf16_t* y1 = (const bf16_t*)(p.ws + WS_HCAT); bf16_t* x1b = (bf16_t*)(p.ws + WS_H0B);
    f32x4 gg[4], bb[4];
#pragma unroll
    for (int i = 0; i < 4; ++i) { gg[i] = *(const f32x4*)(p.ln1_g + 16 * lane + 4 * i); bb[i] = *(const f32x4*)(p.ln1_b + 16 * lane + 4 * i); }
    for (int r0 = gw; r0 < T_; r0 += 4 * nw) {
        u32x4 raw[4][2];
#pragma unroll
        for (int j = 0; j < 4; ++j) { const int r = min(r0 + j * nw, T_ - 1); raw[j][0] = *(const u32x4*)(y1 + (size_t)r * 1024 + 16 * lane); raw[j][1] = *(const u32x4*)(y1 + (size_t)r * 1024 + 16 * lane + 8); }
#pragma unroll
        for (int j = 0; j < 4; ++j) {
            const int r = r0 + j * nw; if (r >= T_) break;
            float v[16];
#pragma unroll
            for (int h = 0; h < 2; ++h) { v[8 * h] = bf_lo(raw[j][h].x); v[8 * h + 1] = bf_hi(raw[j][h].x); v[8 * h + 2] = bf_lo(raw[j][h].y); v[8 * h + 3] = bf_hi(raw[j][h].y);
                v[8 * h + 4] = bf_lo(raw[j][h].z); v[8 * h + 5] = bf_hi(raw[j][h].z); v[8 * h + 6] = bf_lo(raw[j][h].w); v[8 * h + 7] = bf_hi(raw[j][h].w); }
            float sm = 0.f;
#pragma unroll
            for (int i = 0; i < 16; ++i) sm += v[i];
            const float mean = wave_sum(sm) * (1.0f / 1024.0f);
            float q = 0.f;
#pragma unroll
            for (int i = 0; i < 16; ++i) { const float d = v[i] - mean; q += d * d; }
            const float rstd = rsqrtf(wave_sum(q) * (1.0f / 1024.0f) + LN_EPS);
            u32x4 o[2];
#pragma unroll
            for (int h = 0; h < 2; ++h) {
                float y[8];
#pragma unroll
                for (int i = 0; i < 8; ++i) y[i] = (v[8 * h + i] - mean) * rstd * gg[2 * h + (i >> 2)][i & 3] + bb[2 * h + (i >> 2)][i & 3];
                o[h].x = pk_bf16(y[0], y[1]); o[h].y = pk_bf16(y[2], y[3]); o[h].z = pk_bf16(y[4], y[5]); o[h].w = pk_bf16(y[6], y[7]);
            }
            *(u32x4*)(x1b + (size_t)r * 1024 + 16 * lane) = o[0]; *(u32x4*)(x1b + (size_t)r * 1024 + 16 * lane + 8) = o[1];
        }
    }
}

__device__ __forceinline__ unsigned ord_key(float f) { const unsigned u = __float_as_uint(f); return u ^ ((unsigned)((int)u >> 31) | 0x80000000u); }
__device__ __forceinline__ float ord_val(unsigned k) { const unsigned u = (k & 0x80000000u) ? (k ^ 0x80000000u) : ~k; return __uint_as_float(u); }

#define TK_CE(x, a, b) do { const unsigned hi_ = max((x)[a], (x)[b]), lo_ = min((x)[a], (x)[b]); (x)[a] = hi_; (x)[b] = lo_; } while (0)
template <int N> __device__ __forceinline__ void tk_merge_desc(unsigned (&x)[N]) {
#pragma unroll
    for (int k = N / 2; k >= 1; k >>= 1)
#pragma unroll
        for (int i = 0; i < N; ++i) if ((i & k) == 0) TK_CE(x, i, i | k);
}
template <int N> __device__ __forceinline__ void tk_sort_desc(unsigned (&x)[N]) {
#pragma unroll
    for (int sz = 2; sz <= N; sz <<= 1)
#pragma unroll
        for (int k = sz >> 1; k >= 1; k >>= 1)
#pragma unroll
            for (int i = 0; i < N; ++i) { const int l = i ^ k; if (l > i) { if ((i & sz) == 0) TK_CE(x, i, l); else TK_CE(x, l, i); } }
}
__device__ __forceinline__ void tk_top16(const unsigned (&a)[16], const unsigned (&b)[16], unsigned (&o)[16]) {
#pragma unroll
    for (int i = 0; i < 16; ++i) o[i] = max(a[i], b[15 - i]);
    tk_merge_desc<16>(o);
}

__device__ void phase_topk(const Params& p, unsigned char* smem) {
    const bf16_t* qp = (const bf16_t*)(p.ws + WS_HCAT); const bf16_t* subk = (const bf16_t*)(p.ws + WS_SUBK);
    int* idx = (int*)(p.ws + WS_MIX); float* gate = (float*)(p.ws + WS_MIX + 8 * MB); float* ginv = (float*)(p.ws + WS_MIX + 16 * MB);
    const int gw = blockIdx.x * NWAVES + ((int)threadIdx.x >> 6), nw = gridDim.x * NWAVES;
    constexpr int SK_STRIDE = 272, SK_BYTES = 256 * SK_STRIDE;
    {
        const int tid0 = threadIdx.x;
#pragma unroll
        for (int i = 0; i < 8; ++i) { const int c = tid0 + 512 * i, row = c >> 4, ch = c & 15;
            *(u32x4*)(smem + row * SK_STRIDE + ch * 16) = *(const u32x4*)(subk + (size_t)row * 128 + ch * 8); }
        __syncthreads();
    }
    for (int item = gw; item < 4096; item += nw) {
        int tid = threadIdx.x; asm volatile("" : "+v"(tid));
        const int lane = tid & 63, qi = lane & 31, hf = lane >> 5;
        const int R = item * 32 + qi;
        unsigned hf4 = (unsigned)hf << 2; asm volatile("" : "+v"(hf4));
        unsigned sel[2][16];
        bf16x8 qfa[2][8];
#pragma unroll
        for (int pp = 0; pp < 2; ++pp) { const bf16_t* qrow = qp + (size_t)R * 256 + pp * 128 + hf * 8;
#pragma unroll
            for (int s = 0; s < 8; ++s) qfa[pp][s] = *(const bf16x8*)(qrow + s * 16); }
#pragma unroll
        for (int pp = 0; pp < 2; ++pp) {
            bf16x8 qf[8];
#pragma unroll
            for (int s = 0; s < 8; ++s) qf[s] = qfa[pp][s];
            unsigned g[4][16];
#pragma unroll
            for (int nb = 0; nb < 4; ++nb) {
                f32x16 sc;
#pragma unroll
                for (int r = 0; r < 16; ++r) sc[r] = 0.f;
                const unsigned char* krow = smem + (pp * 128 + nb * 32 + qi) * SK_STRIDE + hf * 16;
#pragma unroll
                for (int s = 0; s < 8; ++s) { const bf16x8 kf = *(const bf16x8*)(krow + s * 32); sc = __builtin_amdgcn_mfma_f32_32x32x16_bf16(kf, qf[s], sc, 0, 0, 0); }
#pragma unroll
                for (int r = 0; r < 16; ++r) { const unsigned nbase = (unsigned)(nb * 32 + (r & 3) + 8 * (r >> 2)); g[nb][r] = ((ord_key(sc[r]) & 0xFFFFFF80u) | (127u ^ nbase)) ^ hf4; }
                tk_sort_desc<16>(g[nb]);
                __builtin_amdgcn_sched_barrier(0);
            }
            unsigned m01[16], m23[16], m[16], u[16];
            tk_top16(g[0], g[1], m01); tk_top16(g[2], g[3], m23); tk_top16(m01, m23, m);
#pragma unroll
            for (int i = 0; i < 16; ++i) u[i] = max(m[i], (unsigned)__shfl_xor((int)m[15 - i], 32));
            tk_merge_desc<16>(u);
#pragma unroll
            for (int i = 0; i < 16; ++i) sel[pp][i] = u[i];
            __builtin_amdgcn_sched_barrier(0);
        }
        float av[16], bv[16]; unsigned anb[4] = {0u, 0u, 0u, 0u}, bnb[4] = {0u, 0u, 0u, 0u};
#pragma unroll
        for (int i = 0; i < 16; ++i) { av[i] = ord_val(sel[0][i] & 0xFFFFFF80u); bv[i] = ord_val(sel[1][i] & 0xFFFFFF80u);
            anb[i >> 2] |= (127u - (sel[0][i] & 127u)) << (8 * (i & 3)); bnb[i >> 2] |= (127u - (sel[1][i] & 127u)) << (8 * (i & 3)); }
        unsigned char* tb = smem + SK_BYTES + (tid >> 6) * 2048 + lane * 32;
        *(u32x4*)tb = (u32x4){anb[0], anb[1], anb[2], anb[3]}; *(u32x4*)(tb + 16) = (u32x4){bnb[0], bnb[1], bnb[2], bnb[3]};
#define TK_CK(i, j) ((ord_key(av[i] + bv[j]) & 0xFFFFFF00u) | (unsigned)(255 - ((i) * 16 + (j))))
        unsigned cA[16], cB[16], cC[16], cD[16], m1[16], m2[16], best[16];
#pragma unroll
        for (int i = 0; i < 16; ++i) { cA[i] = TK_CK(i, 0); cB[i] = (i < 15) ? TK_CK(0, i + 1) : 0u; cD[i] = 0u; }
        cC[0] = TK_CK(1, 1); cC[1] = TK_CK(1, 2); cC[2] = TK_CK(1, 3); cC[3] = TK_CK(1, 4); cC[4] = TK_CK(1, 5); cC[5] = TK_CK(1, 6); cC[6] = TK_CK(1, 7);
        cC[7] = TK_CK(2, 1); cC[8] = TK_CK(2, 2); cC[9] = TK_CK(2, 3); cC[10] = TK_CK(2, 4);
        cC[11] = TK_CK(3, 1); cC[12] = TK_CK(3, 2); cC[13] = TK_CK(3, 3); cC[14] = TK_CK(4, 1); cC[15] = TK_CK(4, 2);
        cD[0] = TK_CK(5, 1); cD[1] = TK_CK(6, 1); cD[2] = TK_CK(7, 1);
#undef TK_CK
        tk_sort_desc<16>(cC);
        tk_top16(cA, cB, m1); tk_top16(cC, cD, m2); tk_top16(m1, m2, best);
        const float s0 = ord_val(best[0] & 0xFFFFFF00u);
        float ex[16], sum = 0.f; int eo[16];
#pragma unroll
        for (int k = 0; k < 16; ++k) {
            const unsigned pos = 255u - (best[k] & 255u);
            ex[k] = __expf(ord_val(best[k] & 0xFFFFFF00u) - s0); sum += ex[k];
            eo[k] = (int)tb[pos >> 4] * 128 + (int)tb[16 + (pos & 15)];
        }
        if (hf == 0) {
#pragma unroll
            for (int k = 0; k < 16; k += 4) {
                *(int4*)(idx + (size_t)R * 16 + k) = make_int4(eo[k], eo[k + 1], eo[k + 2], eo[k + 3]);
                *(f32x4*)(gate + (size_t)R * 16 + k) = (f32x4){ex[k], ex[k + 1], ex[k + 2], ex[k + 3]};
            }
            ginv[R] = 1.0f / sum;
        }
#pragma unroll 1
        for (int j = 0; j < 8; j += 4) convert_table_rows4(p, item * 8 + j, lane);
    }
}

typedef __bf16 bf16x2v __attribute__((ext_vector_type(2)));
constexpr int G2_XT_BYTES = 64 * 2048;
constexpr int G2_LIST_OFF = G2_XT_BYTES;
constexpr int G2_LDS_BYTES = G2_XT_BYTES + 8 * 1024 * 4;
constexpr int G2V_ACT_OFF = 96 * 1024;
constexpr int G2V_HILO = 0;
typedef int i32x2 __attribute__((ext_vector_type(2)));
constexpr size_t WS_ACT = WS_POOLED;
__device__ __forceinline__ unsigned g2_key(unsigned ent) { return ((ent >> 26) << 3) | ((ent >> 14) & 7u); }

__device__ __forceinline__ float gelu_as(float v) {
    const float av = fabsf(v), t = __builtin_amdgcn_rcpf(av * 0.2316418882f + 1.0f);
    float q = t * 0.5307027145f + (-0.7265760135f); q = q * t + 0.7107068705f; q = q * t + (-0.142248368f); q = q * t + 0.127414796f; q = q * t;
    const float e = __builtin_amdgcn_exp2f((v * v) * (-0.72134752044f));
    const float m = v * (q * e);
    return v < 0.f ? m : v - m;
}
__device__ __forceinline__ void g2u_issue(const unsigned char* u8, int entreg, int base, int lane, u32x4 (&ub)[8]) {
#pragma unroll
    for (int j = 0; j < 8; ++j) { const unsigned roff = (unsigned)__builtin_amdgcn_readlane(entreg, base + j) >> 7 & 0xfffffc00u;
        ub[j] = *(const u32x4*)(u8 + roff + 16 * lane); }
}
__device__ __forceinline__ float g2u_compute(const unsigned char* xw, int entreg, float sureg, float gsreg, int base, int lane, const u32x4 (&ub)[8]) {
    float s[8];
#pragma unroll
    for (int j = 0; j < 8; ++j) {
        const int slot = (__builtin_amdgcn_readlane(entreg, base + j) >> 14) & 7;
        const u32x4 x = *(const u32x4*)(xw + slot * 1024 + 16 * lane);
        int d = 0;
#pragma unroll
        for (int w = 0; w < 4; ++w) d = __builtin_amdgcn_sdot4((int)ub[j][w], (int)x[w], d, false);
        s[j] = (float)d;
    }
    const float q0 = swap16_add(swap32_add(s[0], s[4]), swap32_add(s[2], s[6]));
    const float q1 = swap16_add(swap32_add(s[1], s[5]), swap32_add(s[3], s[7]));
    const bool b3 = (lane & 8) != 0;
    const float keep = b3 ? q1 : q0, send = b3 ? q0 : q1;
    float r = keep + dpp_f<0x128>(send);
    r += dpp_f<0xB1>(r); r += dpp_f<0x4E>(r); r += dpp_f<0x141>(r);
    const float su = __shfl(sureg, base + (lane >> 3)), gs = __shfl(gsreg, base + (lane >> 3));
    const float hid = r * su;
    return gelu_as(hid) * gs;
}

__device__ __forceinline__ void g2v_issue(const unsigned char* vlane, int e, u32x4 (&vb)[8]) {
    const unsigned char* r = vlane + (size_t)e * 1024;
#pragma unroll
    for (int c = 0; c < 8; ++c) vb[c] = *(const u32x4*)(r + c * 128);
}
__device__ __forceinline__ void g2v_compute(f32x2 (&acc)[8][8], float a, const u32x4 (&vb)[8]) {
    const f32x2 a2 = {a, a};
#pragma unroll
    for (int c = 0; c < 8; ++c)
#pragma unroll
        for (int w = 0; w < 4; ++w) {
            const f32x2 lo = __builtin_amdgcn_cvt_pk_f32_fp8((int)vb[c][w], false), hi = __builtin_amdgcn_cvt_pk_f32_fp8((int)vb[c][w], true);
            asm("v_pk_fma_f32 %0, %1, %2, %0" : "+v"(acc[c][2 * w]) : "v"(a2), "v"(lo));
            asm("v_pk_fma_f32 %0, %1, %2, %0" : "+v"(acc[c][2 * w + 1]) : "v"(a2), "v"(hi));
        }
}

__device__ void phase_gather2(const Params& p, unsigned char* smem) {
    const unsigned char* u8 = p.ws + WS_U8; const unsigned char* v8 = p.ws + WS_V8;
    const f32x2* suv = (const f32x2*)(p.ws + WS_SU);
    const int* idx = (const int*)(p.ws + WS_MIX); const float* gate = (const float*)(p.ws + WS_MIX + 8 * MB); const float* ginv = (const float*)(p.ws + WS_MIX + 16 * MB);
    const bf16_t* x1b = (const bf16_t*)(p.ws + WS_H0B);
    const int wid = __builtin_amdgcn_readfirstlane((int)threadIdx.x >> 6);
    unsigned* lst = (unsigned*)(smem + G2_LIST_OFF) + wid * 1024;
    unsigned* cnt = (unsigned*)smem + wid * 1024;
    unsigned* bas = cnt + 256;
    {
        const int tile = blockIdx.x; if (tile >= T_ / 64) return;
        const int tid = threadIdx.x, lane = tid & 63;
        const int tok0 = tile * 64, tw = tok0 + wid * 8;
        float* isclg = (float*)(p.ws + WS_ACT) + (size_t)tile * 64;
        float* actl = (float*)(smem + G2V_ACT_OFF) + wid * 1024;
        __syncthreads();
        *(u32x4*)(cnt + 4 * lane) = (u32x4){0u, 0u, 0u, 0u};
        __syncthreads();
        {
            unsigned ent[16], rnk[16]; float gv[16];
#pragma unroll
            for (int i = 0; i < 16; ++i) {
                const int slot = i >> 1, k = (i & 1) * 64 + lane;
                const unsigned e = (unsigned)idx[(size_t)(tw + slot) * 128 + k];
                gv[i] = gate[(size_t)(tw + slot) * 128 + k] * ginv[(size_t)(tw + slot) * 8 + (k >> 4)];
                ent[i] = (e << 17) | ((unsigned)slot << 14) | ((unsigned)k << 7);
                rnk[i] = atomicAdd(&cnt[g2_key(ent[i])], 1u);
            }
            __syncthreads();
            {
                const u32x4 c = *(const u32x4*)(cnt + 4 * lane);
                const unsigned tot = c.x + c.y + c.z + c.w; unsigned incl = tot;
#pragma unroll
                for (int o = 1; o < 64; o <<= 1) { const unsigned v = (unsigned)__shfl_up((int)incl, o); if (lane >= o) incl += v; }
                const unsigned ex = incl - tot;
                u32x4 b; b.x = ex; b.y = ex + c.x; b.z = ex + c.x + c.y; b.w = ex + c.x + c.y + c.z;
                *(u32x4*)(bas + 4 * lane) = b;
            }
            __syncthreads();
#pragma unroll
            for (int i = 0; i < 16; ++i) {
                const unsigned key = g2_key(ent[i]);
                lst[bas[key] + rnk[i]] = ent[i];
                actl[bas[key] + rnk[i]] = gv[i];
            }
        }
        __syncthreads();
        unsigned char* xwp = smem + wid * 8 * 1024;
        float* sxw = (float*)(smem + 64 * 1024) + wid * 8;
#pragma unroll 1
        for (int sl = 0; sl < 8; ++sl) {
            const bf16_t* xr = x1b + (size_t)(tw + sl) * 1024 + 16 * lane;
            const u32x4 a = *(const u32x4*)xr, b = *(const u32x4*)(xr + 8);
            const float v[16] = {bf_lo(a.x), bf_hi(a.x), bf_lo(a.y), bf_hi(a.y), bf_lo(a.z), bf_hi(a.z), bf_lo(a.w), bf_hi(a.w), bf_lo(b.x), bf_hi(b.x), bf_lo(b.y), bf_hi(b.y), bf_lo(b.z), bf_hi(b.z), bf_lo(b.w), bf_hi(b.w)};
            float amax = 0.f;
#pragma unroll
            for (int i = 0; i < 16; ++i) amax = fmaxf(amax, fabsf(v[i]));
#pragma unroll
            for (int o = 32; o > 0; o >>= 1) amax = fmaxf(amax, __shfl_xor(amax, o));
            const float sc = amax > 0.f ? 127.0f / amax : 1.0f;
            u32x4 w;
#pragma unroll
            for (int i = 0; i < 4; ++i) w[i] = q8x4(v[4 * i] * sc, v[4 * i + 1] * sc, v[4 * i + 2] * sc, v[4 * i + 3] * sc);
            *(u32x4*)(xwp + sl * 1024 + 16 * lane) = w;
            if (lane == 0) sxw[sl] = amax > 0.f ? amax * (1.0f / 127.0f) : 1.0f;
        }
        {
            const unsigned char* xw = xwp;
            int entA = (int)lst[lane];
            float suA, gsA;
            { const int e = entA >> 17, slot = (entA >> 14) & 7, k = (entA >> 7) & 127; const size_t tk = (size_t)(tw + slot);
              const f32x2 ss = suv[e]; suA = ss.x * sxw[slot]; gsA = actl[lane] * ss.y; (void)tk; (void)k; }
            u32x4 ub0[8], ub1[8], ub2[8], ub3[8];
            g2u_issue(u8, entA, 0, lane, ub0); g2u_issue(u8, entA, 8, lane, ub1); g2u_issue(u8, entA, 16, lane, ub2);
#pragma unroll 1
            for (int chunk = 0; chunk < 16; ++chunk) {
                const bool more = chunk < 15;
                const int entN = (int)lst[(more ? chunk + 1 : chunk) * 64 + lane];
                float suN, gsN;
                { const int e = entN >> 17, slot = (entN >> 14) & 7, k = (entN >> 7) & 127; const size_t tk = (size_t)(tw + slot);
                  const f32x2 ss = suv[e]; suN = ss.x * sxw[slot]; gsN = actl[(more ? chunk + 1 : chunk) * 64 + lane] * ss.y; (void)tk; (void)k; }
                float actchunk = 0.f;
#define G2U_STEP(J, BC, BN) do { if (J + 3 < 8) g2u_issue(u8, entA, (J + 3) * 8, lane, BN); else if (more) g2u_issue(u8, entN, (J + 3 - 8) * 8, lane, BN); \
                    const float a_ = g2u_compute(xw, entA, suA, gsA, J * 8, lane, BC); const float v_ = __shfl(a_, (lane & 7) * 8); actchunk = ((lane >> 3) == J) ? v_ : actchunk; } while (0)
                G2U_STEP(0, ub0, ub3); G2U_STEP(1, ub1, ub0); G2U_STEP(2, ub2, ub1); G2U_STEP(3, ub3, ub2);
                G2U_STEP(4, ub0, ub3); G2U_STEP(5, ub1, ub0); G2U_STEP(6, ub2, ub1); G2U_STEP(7, ub3, ub2);
#undef G2U_STEP
                actl[chunk * 64 + lane] = actchunk;
                entA = entN; suA = suN; gsA = gsN;
            }
        }
        {
            float am[8];
#pragma unroll
            for (int sI = 0; sI < 8; ++sI) am[sI] = 0.f;
#pragma unroll 1
            for (int ch = 0; ch < 16; ++ch) {
                const unsigned e = lst[ch * 64 + lane]; const float a = fabsf(actl[ch * 64 + lane]); const unsigned sl = (e >> 14) & 7u;
#pragma unroll
                for (int sI = 0; sI < 8; ++sI) am[sI] = fmaxf(am[sI], sl == (unsigned)sI ? a : 0.f);
            }
#pragma unroll
            for (int sI = 0; sI < 8; ++sI) {
#pragma unroll
                for (int o = 32; o > 0; o >>= 1) am[sI] = fmaxf(am[sI], __shfl_xor(am[sI], o));
            }
            float sc[8];
#pragma unroll
            for (int sI = 0; sI < 8; ++sI) sc[sI] = am[sI] > 0.f ? 240.0f / am[sI] : 1.0f;
#pragma unroll 1
            for (int ch = 0; ch < 16; ++ch) {
                const unsigned e = lst[ch * 64 + lane]; const unsigned sl = (e >> 14) & 7u;
                float f = sc[0];
#pragma unroll
                for (int sI = 1; sI < 8; ++sI) f = sl == (unsigned)sI ? sc[sI] : f;
                actl[ch * 64 + lane] *= f;
            }
            float myi = 1.0f;
#pragma unroll
            for (int sI = 0; sI < 8; ++sI) myi = (lane == sI) ? (am[sI] > 0.f ? am[sI] * (1.0f / 240.0f) : 1.0f) : myi;
            if (lane < 8) __hip_atomic_store(isclg + wid * 8 + lane, myi, __ATOMIC_RELAXED, __HIP_MEMORY_SCOPE_AGENT);
        }
        asm volatile("s_waitcnt vmcnt(0) lgkmcnt(0)" ::: "memory");
        __syncthreads();
        f32x4 acc[32];
#pragma unroll
        for (int i = 0; i < 32; ++i) acc[i] = (f32x4){0.f, 0.f, 0.f, 0.f};
        const int g = wid >> 1, h = wid & 1;
        unsigned char* stage = smem + wid * 8192;
        {
            const int m = lane & 15, kq = lane >> 4, sel = kq >> 1;
            const unsigned myslot = ((m >> 3) == sel) ? (unsigned)(m & 7) : 8u;
            const unsigned lbase = (unsigned)((2 * g + sel) * 4096 + (kq & 1) * 32);
            const int rr = lane >> 3, pj = lane & 7;
            const unsigned dcol = (unsigned)(512 * h + 16 * pj);
            const unsigned eoff0 = (unsigned)((2 * g) * 4096 + rr * 4), eoff1 = eoff0 + 32u, eoff2 = eoff0 + 4096u, eoff3 = eoff0 + 4096u + 32u;
            const unsigned char* lsts = smem + G2_LIST_OFF; const unsigned char* acts = smem + G2V_ACT_OFF;
            const unsigned wrE = (unsigned)(pj * 128 + ((rr + pj) & 7) * 16), wrO = (unsigned)((pj ^ 1) * 128 + ((rr + pj) & 7) * 16);
            unsigned rotv[8];
            { const unsigned sb = (unsigned)(size_t)((PG8_LAS unsigned char*)smem) + (unsigned)(wid * 8192 + kq * 1024 + 8 * (m & 1));
#pragma unroll
              for (int jj = 0; jj < 8; ++jj) rotv[jj] = sb + (unsigned)(((jj ^ (kq & 1)) * 128) + ((((m >> 1) + jj) & 7) << 4)); }
            unsigned roC[4], roN[4];
            u32x4 vb[4][4];
#define G2V_ENT(off) (*(const unsigned*)(lsts + (off)))
#define G2V_ROFF(RO, J) do { const unsigned jo_ = 64u * (unsigned)(J); \
                RO[0] = ((G2V_ENT(eoff0 + jo_) >> 7) & 0xfffffc00u) + dcol; RO[1] = ((G2V_ENT(eoff1 + jo_) >> 7) & 0xfffffc00u) + dcol; \
                RO[2] = ((G2V_ENT(eoff2 + jo_) >> 7) & 0xfffffc00u) + dcol; RO[3] = ((G2V_ENT(eoff3 + jo_) >> 7) & 0xfffffc00u) + dcol; } while (0)
#define G2V_LOAD(RO, CQ) do { _Pragma("unroll") for (int kk_ = 0; kk_ < 4; ++kk_) vb[CQ][kk_] = *(const u32x4*)(v8 + RO[kk_] + 128u * (CQ)); } while (0)
#define G2V_TR8(OFS) asm volatile("ds_read_b64_tr_b8 %0, %8 offset:" OFS "\n\tds_read_b64_tr_b8 %1, %9 offset:" OFS "\n\tds_read_b64_tr_b8 %2, %10 offset:" OFS "\n\tds_read_b64_tr_b8 %3, %11 offset:" OFS "\n\t" \
                             "ds_read_b64_tr_b8 %4, %12 offset:" OFS "\n\tds_read_b64_tr_b8 %5, %13 offset:" OFS "\n\tds_read_b64_tr_b8 %6, %14 offset:" OFS "\n\tds_read_b64_tr_b8 %7, %15 offset:" OFS "\n\t" \
                             "s_waitcnt lgkmcnt(0)" \
                             : "=&v"(b_[0]), "=&v"(b_[1]), "=&v"(b_[2]), "=&v"(b_[3]), "=&v"(b_[4]), "=&v"(b_[5]), "=&v"(b_[6]), "=&v"(b_[7]) \
                             : "v"(rotv[0]), "v"(rotv[1]), "v"(rotv[2]), "v"(rotv[3]), "v"(rotv[4]), "v"(rotv[5]), "v"(rotv[6]), "v"(rotv[7]) : "memory")
#define G2V_STEP(CQ) do { unsigned char* sb_ = stage + ((CQ) & 1) * 4096; \
                _Pragma("unroll") for (int kk_ = 0; kk_ < 4; ++kk_) *(u32x4*)(sb_ + kk_ * 1024 + ((kk_ & 1) ? wrO : wrE)) = vb[CQ][kk_]; \
                G2V_LOAD(roN, CQ); \
                i32x2 b_[8]; \
                if ((CQ) & 1) G2V_TR8("4096"); else G2V_TR8("0"); \
                _Pragma("unroll") for (int jj_ = 0; jj_ < 8; ++jj_) { const long bb_ = __builtin_bit_cast(long, b_[jj_]); \
                    acc[8 * (CQ) + jj_] = __builtin_amdgcn_mfma_f32_16x16x32_fp8_fp8(Ahi, bb_, acc[8 * (CQ) + jj_], 0, 0, 0); \
                    if (G2V_HILO) acc[8 * (CQ) + jj_] = __builtin_amdgcn_mfma_f32_16x16x32_fp8_fp8(Alo, bb_, acc[8 * (CQ) + jj_], 0, 0, 0); } } while (0)
            G2V_ROFF(roC, 0);
            G2V_LOAD(roC, 0); __builtin_amdgcn_sched_barrier(0); G2V_LOAD(roC, 1); __builtin_amdgcn_sched_barrier(0); G2V_LOAD(roC, 2); __builtin_amdgcn_sched_barrier(0); G2V_LOAD(roC, 3); __builtin_amdgcn_sched_barrier(0);
#pragma unroll 1
            for (int j = 0; j < 64; ++j) {
                G2V_ROFF(roN, j < 63 ? j + 1 : j);
                long Ahi, Alo;
                {
                    const unsigned o_ = lbase + 64u * (unsigned)j;
                    const u32x4 e0 = *(const u32x4*)(lsts + o_), e1 = *(const u32x4*)(lsts + o_ + 16);
                    const f32x4 a0 = *(const f32x4*)(acts + o_), a1 = *(const f32x4*)(acts + o_ + 16);
                    float v[8];
#pragma unroll
                    for (int t = 0; t < 4; ++t) { v[t] = (((e0[t] >> 14) & 7u) == myslot) ? a0[t] : 0.f; v[4 + t] = (((e1[t] >> 14) & 7u) == myslot) ? a1[t] : 0.f; }
                    int h0 = __builtin_amdgcn_cvt_pk_fp8_f32(v[0], v[1], 0, false); h0 = __builtin_amdgcn_cvt_pk_fp8_f32(v[2], v[3], h0, true);
                    int h1 = __builtin_amdgcn_cvt_pk_fp8_f32(v[4], v[5], 0, false); h1 = __builtin_amdgcn_cvt_pk_fp8_f32(v[6], v[7], h1, true);
                    Ahi = (long)(((unsigned long)(unsigned)h1 << 32) | (unsigned long)(unsigned)h0);
                    const f32x2 d0 = __builtin_amdgcn_cvt_pk_f32_fp8(h0, false), d1 = __builtin_amdgcn_cvt_pk_f32_fp8(h0, true), d2 = __builtin_amdgcn_cvt_pk_f32_fp8(h1, false), d3 = __builtin_amdgcn_cvt_pk_f32_fp8(h1, true);
                    int l0 = __builtin_amdgcn_cvt_pk_fp8_f32(v[0] - d0.x, v[1] - d0.y, 0, false); l0 = __builtin_amdgcn_cvt_pk_fp8_f32(v[2] - d1.x, v[3] - d1.y, l0, true);
                    int l1 = __builtin_amdgcn_cvt_pk_fp8_f32(v[4] - d2.x, v[5] - d2.y, 0, false); l1 = __builtin_amdgcn_cvt_pk_fp8_f32(v[6] - d3.x, v[7] - d3.y, l1, true);
                    Alo = (long)(((unsigned long)(unsigned)l1 << 32) | (unsigned long)(unsigned)l0);
                }
                G2V_STEP(0); G2V_STEP(1); G2V_STEP(2); G2V_STEP(3);
#pragma unroll
                for (int kk = 0; kk < 4; ++kk) roC[kk] = roN[kk];
            }
#undef G2V_ENT
#undef G2V_ROFF
#undef G2V_LOAD
#undef G2V_STEP
#undef G2V_TR8
        }
        {
            const int q = lane >> 4, n = lane & 15;
            float isc[4];
#pragma unroll
            for (int r = 0; r < 4; ++r) isc[r] = __hip_atomic_load(isclg + (2 * g + (q >> 1)) * 8 + 4 * (q & 1) + r, __ATOMIC_RELAXED, __HIP_MEMORY_SCOPE_AGENT);
            f32x4 y[4][8];
#pragma unroll
            for (int r = 0; r < 4; ++r) {
                u32x2 xv[8];
#pragma unroll
                for (int i = 0; i < 8; ++i) xv[i] = *(const u32x2*)(x1b + (size_t)(tok0 + 16 * g + 4 * (i >> 1) + r) * 1024 + 512 * h + 256 * (i & 1) + 4 * lane);
                float* sw = (float*)stage + q * 512 + n;
#pragma unroll
                for (int nt = 0; nt < 32; ++nt) sw[16 * nt] = acc[nt][r] * isc[r];
#pragma unroll
                for (int i = 0; i < 8; ++i) {
                    const f32x4 f = *(const f32x4*)((const float*)stage + i * 256 + 4 * lane);
                    y[r][i][0] = f[0] + DN_ALPHA * bf_lo(xv[i].x); y[r][i][1] = f[1] + DN_ALPHA * bf_hi(xv[i].x);
                    y[r][i][2] = f[2] + DN_ALPHA * bf_lo(xv[i].y); y[r][i][3] = f[3] + DN_ALPHA * bf_hi(xv[i].y);
                }
                __builtin_amdgcn_sched_barrier(0);
            }
            float* red = (float*)(smem + G2V_ACT_OFF) + wid * 1024; const float* redp = (const float*)(smem + G2V_ACT_OFF) + (wid ^ 1) * 1024;
            float sm[4][4];
#pragma unroll
            for (int r = 0; r < 4; ++r)
#pragma unroll
                for (int t = 0; t < 4; ++t) { const f32x4 a = y[r][2 * t], b = y[r][2 * t + 1]; sm[r][t] = wave_sum(((a[0] + a[1]) + (a[2] + a[3])) + ((b[0] + b[1]) + (b[2] + b[3]))); }
            __syncthreads();
            if (lane == 0) {
#pragma unroll
                for (int r = 0; r < 4; ++r)
#pragma unroll
                    for (int t = 0; t < 4; ++t) red[4 * t + r] = sm[r][t];
            }
            __syncthreads();
            float mean[4][4], q2[4][4];
#pragma unroll
            for (int r = 0; r < 4; ++r)
#pragma unroll
                for (int t = 0; t < 4; ++t) {
                    mean[r][t] = (sm[r][t] + redp[4 * t + r]) * (1.0f / 1024.0f);
                    float qq = 0.f;
#pragma unroll
                    for (int u = 0; u < 2; ++u)
#pragma unroll
                        for (int e = 0; e < 4; ++e) { y[r][2 * t + u][e] -= mean[r][t]; qq += y[r][2 * t + u][e] * y[r][2 * t + u][e]; }
                    q2[r][t] = wave_sum(qq);
                }
            if (lane == 0) {
#pragma unroll
                for (int r = 0; r < 4; ++r)
#pragma unroll
                    for (int t = 0; t < 4; ++t) red[16 + 4 * t + r] = q2[r][t];
            }
            __syncthreads();
            f32x4 gg[2], bb[2];
#pragma unroll
            for (int u = 0; u < 2; ++u) { gg[u] = *(const f32x4*)(p.ln2_g + 512 * h + 256 * u + 4 * lane); bb[u] = *(const f32x4*)(p.ln2_b + 512 * h + 256 * u + 4 * lane); }
#pragma unroll
            for (int r = 0; r < 4; ++r)
#pragma unroll
                for (int t = 0; t < 4; ++t) {
                    const float rstd = rsqrtf((q2[r][t] + redp[16 + 4 * t + r]) * (1.0f / 1024.0f) + LN_EPS);
#pragma unroll
                    for (int u = 0; u < 2; ++u)
                        *(f32x4*)(p.out + (size_t)(tok0 + 16 * g + 4 * t + r) * 1024 + 512 * h + 256 * u + 4 * lane) = y[r][2 * t + u] * rstd * gg[u] + bb[u];
                }
        }
    }
}

#define XB_TMO      128
#define XB_XCNT(j)  (256  + 64 * (j))
#define XB_XSUB(j)  (1280 + 64 * (j))
#define XB_XGEN(j)  (2304 + 64 * (j))
#define XB_TOP      3328
#define XB_TOPGEN   3392
#define XCD_BAR_WORDS 3456
#define XB_SPIN_CAP (1u << 18)
#define LAS __attribute__((address_space(3)))
__device__ __forceinline__ unsigned xb_ld(unsigned* p)              { return __hip_atomic_load(p, __ATOMIC_RELAXED, __HIP_MEMORY_SCOPE_AGENT); }
__device__ __forceinline__ unsigned xb_add(unsigned* p, unsigned v) { return __hip_atomic_fetch_add(p, v, __ATOMIC_RELAXED, __HIP_MEMORY_SCOPE_AGENT); }
__device__ __forceinline__ unsigned xb_xcc_id() { return (unsigned)__builtin_amdgcn_s_getreg((3 << 11) | 20) & 0xFu; }
#define XB_SPIN(cond, bar) do { unsigned _sp = 0; while (cond) { __builtin_amdgcn_s_sleep(1); \
    if ((++_sp & 255u) == 0u) { if (xb_ld(&(bar)[XB_TMO])) break; if (_sp > XB_SPIN_CAP) { atomicAdd(&(bar)[XB_TMO], 1u); break; } } } } while (0)
struct XcdBarrier { unsigned* bar; unsigned x; volatile LAS unsigned* st; };
__device__ __forceinline__ XcdBarrier xcd_barrier_post(unsigned* bar, volatile LAS unsigned* st) {
    XcdBarrier b; b.bar = bar; b.x = xb_xcc_id(); b.st = st;
    if (threadIdx.x == 0) (void)xb_add(&bar[XB_XCNT(b.x)], 1u);
    return b;
}
__device__ __forceinline__ void xcd_barrier_complete(unsigned* bar, unsigned x, unsigned& nloc, unsigned& nx) {
    const unsigned G = gridDim.x * gridDim.y * gridDim.z;
    unsigned sum, cnt, mine, sp = 0u;
    for (;;) {
        sum = 0u; cnt = 0u; mine = 0u;
#pragma unroll
        for (unsigned j = 0; j < 16; ++j) { const unsigned c = xb_ld(&bar[XB_XCNT(j)]); sum += c; cnt += (c > 0u) ? 1u : 0u; mine = (j == x) ? c : mine; }
        if (sum == G) break;
        __builtin_amdgcn_s_sleep(1);
        if ((++sp & 255u) == 0u) { if (xb_ld(&bar[XB_TMO])) break; if (sp > XB_SPIN_CAP) { atomicAdd(&bar[XB_TMO], 1u); break; } }
    }
    nloc = mine > 0u ? mine : 1u; nx = cnt > 0u ? cnt : 1u;
}
__device__ __forceinline__ void xcd_barrier(const XcdBarrier& b) {
    asm volatile("s_waitcnt vmcnt(0)" ::: "memory");
    __syncthreads();
    if (threadIdx.x == 0) {
        unsigned* bar = b.bar;
        __builtin_amdgcn_s_waitcnt(0);
        unsigned nloc = b.st[0], nx = b.st[1];
        if (nloc == 0u) { xcd_barrier_complete(bar, b.x, nloc, nx); b.st[0] = nloc; b.st[1] = nx; }
        const unsigned old = xb_add(&bar[XB_XSUB(b.x)], 1u);
        const unsigned gen = old / nloc;
        if (old + 1u == (gen + 1u) * nloc) {
            __builtin_amdgcn_fence(__ATOMIC_RELEASE, "agent");
            asm volatile("s_waitcnt vmcnt(0)" ::: "memory");
            const unsigned og = xb_add(&bar[XB_TOP], 1u);
            const unsigned tg = og / nx;
            if (og + 1u == (tg + 1u) * nx) xb_add(&bar[XB_TOPGEN], 1u);
            else XB_SPIN(xb_ld(&bar[XB_TOPGEN]) == tg, bar);
            __builtin_amdgcn_fence(__ATOMIC_ACQUIRE, "agent");
            xb_add(&bar[XB_XGEN(b.x)], 1u);
            asm volatile("s_waitcnt vmcnt(0)" ::: "memory");
        } else {
            XB_SPIN(xb_ld(&bar[XB_XGEN(b.x)]) == gen, bar);
            __builtin_amdgcn_fence(__ATOMIC_ACQUIRE, "agent");
            asm volatile("s_waitcnt vmcnt(0)" ::: "memory");
        }
    }
    __syncthreads();
}

__device__ __forceinline__ void run_phase(int ph, const Params& p, unsigned char* smem, bool dummy = false, const XcdBarrier* rb = nullptr) {
    if (ph == 0) phase_prep(p, smem);
    if (ph == 1) { pg8::Gemm g{(const bf16_t*)(p.ws + WS_H0B), (const bf16_t*)(p.ws + WS_WIN), T_, 2048, 1024}; pg8::StaticOrder S; S.init(T_, 2048, gridDim.x, blockIdx.x);
        EpiG1 e{(bf16_t*)(p.ws + WS_HCAT), (bf16_t*)(p.ws + WS_VT)}; pg8::gemm_phase((PG8_LAS unsigned char*)smem, g, S, e); }
    if (ph == 2) {
        phase_attn(p, smem); phase_poolprep(p);
        asm volatile("s_waitcnt vmcnt(0)" ::: "memory"); __syncthreads();
        EpiPool e{(bf16_t*)(p.ws + WS_MIX), p.pool_b, p.pool_scale};
        gemm_phase((const bf16_t*)(p.ws + WS_POOLED), 512, 256, (const bf16_t*)(p.ws + WS_POOLW), 256, 65536, T_, 256, 256, 2, e, smem);
    }
    if (ph == 4) { pg8::Gemm g{(const bf16_t*)(p.ws + WS_MIX), (const bf16_t*)(p.ws + WS_WOUT), T_, 1024, 1024}; pg8::StaticOrder S; S.init(T_, 1024, gridDim.x, blockIdx.x);
        EpiG2 e{(const bf16_t*)(p.ws + WS_H0B), (bf16_t*)(p.ws + WS_HCAT)}; pg8::gemm_phase((PG8_LAS unsigned char*)smem, g, S, e); }
    if (ph == 5) phase_ln1(p);
    if (ph == 6) { pg8::Gemm g{(const bf16_t*)(p.ws + WS_H0B), (const bf16_t*)(p.ws + WS_WQ), T_, 2048, 1024}; pg8::StaticOrder S; S.init(T_, 2048, gridDim.x, blockIdx.x);
        EpiG3 e{(bf16_t*)(p.ws + WS_HCAT), 2048}; pg8::gemm_phase((PG8_LAS unsigned char*)smem, g, S, e); }
    if (ph == 7) phase_topk(p, smem);
    if (ph == 8) phase_gather2(p, smem);
}

constexpr int PROBE_PH = -1;
constexpr int LDS_BYTES = G2_LDS_BYTES;
__global__ void __launch_bounds__(NTHREADS, 2) k_mega(Params p) {
    extern __shared__ __attribute__((aligned(16))) unsigned char smem[];
    volatile LAS unsigned* st = (volatile LAS unsigned*)(smem + LDS_BYTES - 16);
    if (threadIdx.x < 4) st[threadIdx.x] = 0u;
    __syncthreads();
    const XcdBarrier bar = xcd_barrier_post((unsigned*)(p.ws + WS_CTL), st);
    if (PROBE_PH == 0) run_phase(0, p, smem, true);
    run_phase(0, p, smem); xcd_barrier(bar);
    if (PROBE_PH == 1) run_phase(1, p, smem, true);
    run_phase(1, p, smem); xcd_barrier(bar);
    if (PROBE_PH == 2) run_phase(2, p, smem, true);
    run_phase(2, p, smem); xcd_barrier(bar);
    if (PROBE_PH == 4) run_phase(4, p, smem, true);
    run_phase(4, p, smem); xcd_barrier(bar);
    if (PROBE_PH == 5) run_phase(5, p, smem, true);
    run_phase(5, p, smem); xcd_barrier(bar);
    if (PROBE_PH == 6) run_phase(6, p, smem, true);
    run_phase(6, p, smem); xcd_barrier(bar);
    if (PROBE_PH == 7) run_phase(7, p, smem, true);
    run_phase(7, p, smem); xcd_barrier(bar);
    if (PROBE_PH == 8) run_phase(8, p, smem, true);
    run_phase(8, p, smem, false, nullptr);
}

extern "C" void kernel_launch(void* const* d_in, const int* in_sizes, int n_in, void* d_out, int out_size, void* d_ws, size_t ws_size, hipStream_t stream) {
    if (n_in != 16 || out_size != T_ * D_ || ws_size < WS_END) {
        fprintf(stderr, "kernel_launch: unexpected problem (n_in %d, out %d, ws %zu < %zu)\n", n_in, out_size, ws_size, (size_t)WS_END);
        return;
    }
    static int grid_blocks = 0;
    if (!grid_blocks) {
        int dev = 0, cus = 0, per_cu = 0;
        hipGetDevice(&dev);
        hipDeviceGetAttribute(&cus, hipDeviceAttributeMultiprocessorCount, dev);
        if (hipFuncSetAttribute((const void*)k_mega, hipFuncAttributeMaxDynamicSharedMemorySize, LDS_BYTES) != hipSuccess) { fprintf(stderr, "kernel_launch: hipFuncSetAttribute failed\n"); grid_blocks = -1; return; }
        (void)hipOccupancyMaxActiveBlocksPerMultiprocessor(&per_cu, (const void*)k_mega, NTHREADS, LDS_BYTES);
        if (per_cu < 1) { fprintf(stderr, "kernel_launch: occupancy query says %d blocks per CU\n", per_cu); grid_blocks = -1; }
        else grid_blocks = cus;
    }
    if (grid_blocks < 0) return;
    Params p{};
    p.x = (const float*)d_in[0]; p.ln0_g = (const float*)d_in[1]; p.ln0_b = (const float*)d_in[2]; p.w_in = (const float*)d_in[3];
    p.pool_w = (const float*)d_in[4]; p.pool_b = (const float*)d_in[5]; p.pool_scale = (const float*)d_in[6]; p.w_out = (const float*)d_in[7];
    p.ln1_g = (const float*)d_in[8]; p.ln1_b = (const float*)d_in[9]; p.wq = (const float*)d_in[10]; p.subk = (const float*)d_in[11];
    p.pu = (const float*)d_in[12]; p.pv = (const float*)d_in[13]; p.ln2_g = (const float*)d_in[14]; p.ln2_b = (const float*)d_in[15];
    p.out = (float*)d_out; p.ws = (unsigned char*)d_ws;
    (void)hipMemsetAsync((unsigned char*)d_ws + WS_CTL, 0, 16384, stream);
    void* args[] = {&p};
    hipError_t e = hipLaunchCooperativeKernel((const void*)k_mega, dim3(grid_blocks), dim3(NTHREADS), args, LDS_BYTES, stream);
    if (e != hipSuccess) fprintf(stderr, "kernel_launch: cooperative launch failed: %s (grid %d)\n", hipGetErrorString(e), grid_blocks);
}
```
